# Optimizing an MI355X kernel written in HIP

```python
import jax, jax.numpy as jnp
from jax import lax
import numpy as np

D_MODEL = 2048
BATCH = 4
SEQ = 4096
DEPTH = 2

CHUNK = 64
Q_BLOCK = 128
SB_HEADS = 8
SB_HEAD_DIM = 128
SB_WIDTH = SB_HEADS * SB_HEAD_DIM
MLA_HEADS = 8
MLA_NOPE = 128
MLA_ROPE = 64
MLA_V = 128
MLA_Q_LORA = 768
MLA_KV_LORA = 512
ROPE_THETA = 10000.0
D_FF = 5632
CONV_WIDTH = 3
EPS = 1e-6
IN_SPLITS = [SB_WIDTH, SB_WIDTH, SB_WIDTH, MLA_Q_LORA, MLA_KV_LORA, MLA_ROPE, D_MODEL, D_MODEL]
IN_COLS = int(sum(IN_SPLITS))

kernel_name = "hybrid_stickbreak_mla_convffn"


def rms_norm(x, g):
    xf = x.astype(jnp.float32)
    y = xf * lax.rsqrt(jnp.mean(xf * xf, axis=-1, keepdims=True) + EPS)
    return (y * g.astype(jnp.float32)).astype(x.dtype)


def rope_tables(seq, dim, dtype):
    inv = 1.0 / (ROPE_THETA ** (jnp.arange(0, dim, 2, dtype=jnp.float32) / dim))
    ang = jnp.arange(seq, dtype=jnp.float32)[:, None] * inv[None, :]
    return jnp.cos(ang).astype(dtype), jnp.sin(ang).astype(dtype)


def apply_rope(x, cos, sin):
    x1, x2 = jnp.split(x, 2, axis=-1)
    return jnp.concatenate([x1 * cos - x2 * sin, x1 * sin + x2 * cos], axis=-1)


def to_heads(t, n_heads):
    b, s, _ = t.shape
    return t.reshape(b, s, n_heads, -1).transpose(0, 2, 1, 3)


def from_heads(t):
    b, h, s, d = t.shape
    return t.transpose(0, 2, 1, 3).reshape(b, s, h * d)


def stick_breaking_attention(q, k, v):
    s_len = q.shape[2]
    scale = q.shape[-1] ** -0.5
    outs = []
    for blk in range(s_len // Q_BLOCK):
        q0 = blk * Q_BLOCK
        end = q0 + Q_BLOCK
        z = jnp.einsum('bhqd,bhkd->bhqk', q[:, :, q0:end], k[:, :, :end]).astype(jnp.float32) * scale
        qpos = q0 + jnp.arange(Q_BLOCK)[:, None]
        kpos = jnp.arange(end)[None, :]
        mask = kpos < qpos
        log_fail = jnp.where(mask, jax.nn.log_sigmoid(-z), 0.0)
        suffix = lax.cumsum(log_fail, axis=3, reverse=True) - log_fail
        a = jnp.where(mask, jnp.exp(jax.nn.log_sigmoid(z) + suffix), 0.0)
        outs.append(jnp.einsum('bhqk,bhkd->bhqd', a.astype(v.dtype), v[:, :, :end]))
    return jnp.concatenate(outs, axis=2)


def latent_attention(q_nope, q_rope, k_nope, k_rope, v):
    s_len = q_nope.shape[2]
    scale = (MLA_NOPE + MLA_ROPE) ** -0.5
    outs = []
    for blk in range(s_len // Q_BLOCK):
        q0 = blk * Q_BLOCK
        end = q0 + Q_BLOCK
        s_nope = jnp.einsum('bhqd,bhkd->bhqk', q_nope[:, :, q0:end], k_nope[:, :, :end])
        s_rope = jnp.einsum('bhqd,bkd->bhqk', q_rope[:, :, q0:end], k_rope[:, :end])
        s = (s_nope.astype(jnp.float32) + s_rope.astype(jnp.float32)) * scale
        qchunk = (q0 + jnp.arange(Q_BLOCK))[:, None] // CHUNK
        kchunk = jnp.arange(end)[None, :] // CHUNK
        s = jnp.where(kchunk <= qchunk, s, -jnp.inf)
        p = jax.nn.softmax(s, axis=-1)
        outs.append(jnp.einsum('bhqk,bhkd->bhqd', p.astype(v.dtype), v[:, :, :end]))
    return jnp.concatenate(outs, axis=2)


def causal_depthwise_conv(u, w, b):
    s_len = u.shape[1]
    up = jnp.pad(u, ((0, 0), (CONV_WIDTH - 1, 0), (0, 0)))
    acc = b + w[0] * up[:, 0:s_len]
    for i in range(1, CONV_WIDTH):
        acc = acc + w[i] * up[:, i:i + s_len]
    return acc


def hybrid_layer(x, cos, sin, norm1_g, w_in, b_gate, q_norm_g, w_uq, kv_norm_g, w_ukv,
                 w_proj_sb, w_proj_mla, w_out, norm2_g, w_up, conv_w, conv_b, w_down):
    b, s, _ = x.shape
    h = rms_norm(x, norm1_g)
    proj = h @ w_in
    cuts = [int(c) for c in np.cumsum(IN_SPLITS)[:-1]]
    sb_q, sb_k, sb_v, c_q, c_kv, k_rope, g_sb, g_mla = jnp.split(proj, cuts, axis=-1)

    o_sb = stick_breaking_attention(to_heads(sb_q, SB_HEADS), to_heads(sb_k, SB_HEADS),
                                    to_heads(sb_v, SB_HEADS))
    o_sb = from_heads(o_sb)

    q = to_heads(rms_norm(c_q, q_norm_g) @ w_uq, MLA_HEADS)
    q_nope, q_rope = q[..., :MLA_NOPE], apply_rope(q[..., MLA_NOPE:], cos, sin)
    kv = to_heads(rms_norm(c_kv, kv_norm_g) @ w_ukv, MLA_HEADS)
    k_nope, v = kv[..., :MLA_NOPE], kv[..., MLA_NOPE:]
    k_rope = apply_rope(k_rope, cos, sin)
    o_mla = from_heads(latent_attention(q_nope, q_rope, k_nope, k_rope, v))

    gate_sb = jax.nn.sigmoid(g_sb + b_gate[:D_MODEL])
    gate_mla = jax.nn.sigmoid(g_mla + b_gate[D_MODEL:])
    mixed = gate_sb * (o_sb @ w_proj_sb) + gate_mla * (o_mla @ w_proj_mla)
    x = x + mixed @ w_out

    h = rms_norm(x, norm2_g)
    u = causal_depthwise_conv(h @ w_up, conv_w, conv_b)
    gate, val = jnp.split(u, 2, axis=-1)
    x = x + (jax.nn.silu(gate) * val) @ w_down
    return x


def setup_inputs(seed: int = 0) -> dict:
    key = jax.random.key(seed)
    ks = jax.random.split(key, 20)
    f32 = jnp.float32

    def w(k, shape, fan_in):
        return jax.random.normal(k, shape, f32) * (fan_in ** -0.5)

    def gain(k, shape):
        return 1.0 + 0.02 * jax.random.normal(k, shape, f32)

    return {
        "x": jax.random.normal(ks[0], (BATCH, SEQ, D_MODEL), f32),
        "norm1_g": gain(ks[1], (DEPTH, D_MODEL)),
        "w_in": w(ks[2], (DEPTH, D_MODEL, IN_COLS), D_MODEL),
        "b_gate": 0.02 * jax.random.normal(ks[3], (DEPTH, 2 * D_MODEL), f32),
        "q_norm_g": gain(ks[4], (DEPTH, MLA_Q_LORA)),
        "w_uq": w(ks[5], (DEPTH, MLA_Q_LORA, MLA_HEADS * (MLA_NOPE + MLA_ROPE)), MLA_Q_LORA),
        "kv_norm_g": gain(ks[6], (DEPTH, MLA_KV_LORA)),
        "w_ukv": w(ks[7], (DEPTH, MLA_KV_LORA, MLA_HEADS * (MLA_NOPE + MLA_V)), MLA_KV_LORA),
        "w_proj_sb": w(ks[8], (DEPTH, SB_WIDTH, D_MODEL), SB_WIDTH),
        "w_proj_mla": w(ks[9], (DEPTH, MLA_HEADS * MLA_V, D_MODEL), MLA_HEADS * MLA_V),
        "w_out": w(ks[10], (DEPTH, D_MODEL, D_MODEL), D_MODEL),
        "norm2_g": gain(ks[11], (DEPTH, D_MODEL)),
        "w_up": w(ks[12], (DEPTH, D_MODEL, 2 * D_FF), D_MODEL),
        "conv_w": w(ks[13], (DEPTH, CONV_WIDTH, 2 * D_FF), CONV_WIDTH),
        "conv_b": 0.02 * jax.random.normal(ks[14], (DEPTH, 2 * D_FF), f32),
        "w_down": w(ks[15], (DEPTH, D_FF, D_MODEL), D_FF),
        "final_g": gain(ks[16], (D_MODEL,)),
    }


def reference(x, norm1_g, w_in, b_gate, q_norm_g, w_uq, kv_norm_g, w_ukv, w_proj_sb,
              w_proj_mla, w_out, norm2_g, w_up, conv_w, conv_b, w_down, final_g):
    cos, sin = rope_tables(x.shape[1], MLA_ROPE, x.dtype)
    for l in range(DEPTH):
        x = hybrid_layer(x, cos, sin, norm1_g[l], w_in[l], b_gate[l], q_norm_g[l], w_uq[l],
                         kv_norm_g[l], w_ukv[l], w_proj_sb[l], w_proj_mla[l], w_out[l],
                         norm2_g[l], w_up[l], conv_w[l], conv_b[l], w_down[l])
    return rms_norm(x, final_g)
```

```cpp
#include <hip/hip_runtime.h>
#include <hip/hip_cooperative_groups.h>
#include <cstdio>
#include <cstdint>
#include <cmath>
namespace cg = cooperative_groups;
constexpr int NWAVES = 8, NTHR = 512;
constexpr int T_ = 16384, SEQ_ = 4096, DM = 2048, DFF = 5632, NIN = 8704, NINSRC = 8512;
constexpr size_t MiB = 1u << 20;
constexpr size_t WS_SSQ = 0;
constexpr size_t WS_ROPE = 1 * MiB;
constexpr size_t WS_WIN = 2 * MiB, WS_WUQ = 36 * MiB, WS_WUKV = WS_WUQ + 2304 * 1024, WS_WSB = WS_WUKV + 2 * MiB, WS_WMLA = WS_WSB + 4 * MiB, WS_WOUT = WS_WMLA + 4 * MiB,
                 WS_WUP = WS_WOUT + 8 * MiB, WS_WDN = WS_WUP + 44 * MiB;
constexpr size_t W_STRIDE = 121 * MiB;
constexpr size_t WS_BAR = 512 * 1024;
constexpr size_t WS_X1 = 244 * MiB;
constexpr size_t WS_R = 372 * MiB;
constexpr size_t WS_HA = WS_R, WS_KV = WS_R;
constexpr size_t WS_SBQ = WS_R + 64 * MiB, WS_SBK = WS_R + 96 * MiB, WS_SBV = WS_R + 128 * MiB, WS_MIX = WS_SBK;
constexpr size_t WS_CQ = WS_R + 160 * MiB, WS_CKV = WS_R + 184 * MiB, WS_OMLA = WS_CQ;
constexpr size_t WS_KR = WS_R + 200 * MiB, WS_GSB = WS_R + 202 * MiB, WS_GMLA = WS_R + 266 * MiB, WS_QM = WS_X1;
constexpr size_t WS_ACT = WS_R + 64 * MiB, WS_YL = WS_R + 240 * MiB, WS_YF = WS_R + 246 * MiB;
constexpr size_t WS_SSQP = WS_R + 330 * MiB;
constexpr size_t WS_END = WS_R + 332 * MiB;

namespace pg8 {
#define PG8_LAS __attribute__((address_space(3)))
typedef unsigned short bf16_t;
typedef short bf16x8 __attribute__((ext_vector_type(8)));
typedef float f32x4 __attribute__((ext_vector_type(4)));
typedef unsigned u32x4 __attribute__((ext_vector_type(4)));
constexpr int BM = 256, BK = 64, HALF = 128, HTB = HALF * BK * 2  , STAGE_BYTES = 8 * HTB, NXCD = 8, WGM = 8;

__host__ __device__ __forceinline__ int lds_byte(int r, int c) { const int st = (r >> 4) * 2 + (c >> 5), rr = r & 15, cc = c & 31, ob = rr * 64 + cc * 2; return st * 1024 + (ob ^ (((ob >> 9) & 1) << 5)); }
__host__ __device__ __forceinline__ void stage_rc(int b, int& R, int& C) { const int st = b / 1024, sb = b % 1024, swz = sb ^ (((sb >> 9) & 1) << 5); R = (st >> 1) * 16 + swz / 64; C = (st & 1) * 32 + (swz % 64) / 2; }
__host__ __device__ __forceinline__ int perm32(int rho) { const int n = rho >> 4, i = rho & 15; return 8 * (i >> 2) + 4 * n + (i & 3); }

struct Unit { int pm, pn; };
struct Gemm { const bf16_t* A; const bf16_t* Bt; int M, N, K; };

struct StaticOrder {
    int nM, nN, nwg, G, c;
    __host__ __device__ void init(int M, int N, int G_, int c_) { nM = M / BM; nN = N / BM; nwg = nM * nN; G = G_; c = c_; }
    __host__ __device__ bool next(int i, Unit& u) const {
        const long L = (long)i * G + c; if (L >= nwg) return false;
        int wgid = (int)L; { const int q = nwg / NXCD, r = nwg % NXCD, xcd = wgid % NXCD, off = wgid / NXCD; wgid = (xcd < r ? xcd * (q + 1) : r * (q + 1) + (xcd - r) * q) + off; }
        const int nig = WGM * nN, gid = wgid / nig, fm = gid * WGM, gsz = (nM - fm) < WGM ? (nM - fm) : WGM;
        u.pm = fm + ((wgid % nig) % gsz); u.pn = (wgid % nig) / gsz; return true;
    }
    __device__ __forceinline__ void a_ready(const Unit&) const {}
    __device__ __forceinline__ void done(const Unit&) const {}
};
typedef float f32x2_cv __attribute__((ext_vector_type(2))); typedef __bf16 bf16x2_cv __attribute__((ext_vector_type(2)));
__device__ __forceinline__ unsigned cvt_pk_bf16(float lo, float hi) { const f32x2_cv v = {lo, hi}; const bf16x2_cv b = __builtin_convertvector(v, bf16x2_cv); return __builtin_bit_cast(unsigned, b); }
typedef float f32x2 __attribute__((ext_vector_type(2)));
typedef unsigned u32x2_ __attribute__((ext_vector_type(2)));
__device__ __forceinline__ float xsum32(float v) { const u32x2_ r = __builtin_amdgcn_permlane32_swap(__float_as_uint(v), __float_as_uint(v), false, false); return __uint_as_float(r[0]) + __uint_as_float(r[1]); }
__device__ __forceinline__ float xsum16(float v) { const u32x2_ r = __builtin_amdgcn_permlane16_swap(__float_as_uint(v), __float_as_uint(v), false, false); return __uint_as_float(r[0]) + __uint_as_float(r[1]); }
__device__ __forceinline__ float xmax32(float v) { const u32x2_ r = __builtin_amdgcn_permlane32_swap(__float_as_uint(v), __float_as_uint(v), false, false); return fmaxf(__uint_as_float(r[0]), __uint_as_float(r[1])); }
__device__ __forceinline__ float xother32(float v, int hi) { const u32x2_ r = __builtin_amdgcn_permlane32_swap(__float_as_uint(v), __float_as_uint(v), false, false); return __uint_as_float(hi ? r[0] : r[1]); }
template <int CTRL> __device__ __forceinline__ float dpp_(float v) { return __uint_as_float(__builtin_amdgcn_update_dpp(0u, __float_as_uint(v), CTRL, 0xf, 0xf, false)); }
__device__ __forceinline__ float wave_sum_(float v) { v += dpp_<0xB1>(v); v += dpp_<0x4E>(v); v += dpp_<0x141>(v); v += dpp_<0x140>(v); v = xsum16(v); return xsum32(v); }
__device__ __forceinline__ u32x4 pack8(const f32x4 v0, const f32x4 v1) { u32x4 w; w.x = cvt_pk_bf16(v0[0], v0[1]); w.y = cvt_pk_bf16(v0[2], v0[3]); w.z = cvt_pk_bf16(v1[0], v1[1]); w.w = cvt_pk_bf16(v1[2], v1[3]); return w; }
__device__ __forceinline__ float bf_lo(unsigned w) { return __uint_as_float(w << 16); }
__device__ __forceinline__ float bf_hi(unsigned w) { return __uint_as_float(w & 0xffff0000u); }
__device__ __forceinline__ float sigmoidf_(float x) { return __builtin_amdgcn_rcpf(1.0f + __builtin_amdgcn_exp2f(-1.4426950408889634f * x)); }

#ifdef DBG_SWAPKV
#define DBG_SWAP(x) ((x) == 0 ? 0 : 3 - (x))
#else
#define DBG_SWAP(x) (x)
#endif
constexpr float SBQ_SCALE = 0.12751743082459868f;
constexpr float MLAQ_SCALE = 0.10411754627697264f;
constexpr float EPS_ = 1e-6f;

struct EpiInProj {
    static constexpr bool PERM = true, AFTER_DRAIN = false, APERM = false;
    unsigned char* ws; float *ssq_q, *ssq_kv; const float* bgate;
    template <int LDC, bool SSQ, int NSLOT = 1> static __device__ __forceinline__ void plain(const f32x4 (&acc)[2][2][4][2], bf16_t* dst, float* ssq, int rowb, int fq, float sc) {
#pragma unroll
        for (int ai = 0; ai < 2; ++ai)
#pragma unroll
            for (int m = 0; m < 4; ++m) { const int row = rowb + ai * HALF + m * 16; float ss = 0.f;
#pragma unroll
                for (int bj = 0; bj < 2; ++bj) { const f32x4 v0 = acc[ai][bj][m][0] * sc, v1 = acc[ai][bj][m][1] * sc;
                    if (SSQ) ss += (v0[0] * v0[0] + v0[1] * v0[1]) + (v0[2] * v0[2] + v0[3] * v0[3]) + (v1[0] * v1[0] + v1[1] * v1[1]) + (v1[2] * v1[2] + v1[3] * v1[3]);
                    *(u32x4*)(dst + (size_t)row * LDC + bj * HALF) = pack8(v0, v1); }
                if (SSQ) { ss = xsum16(ss); ss = xsum32(ss); if (fq == 0) ssq[(size_t)row * NSLOT] = ss; }
                asm volatile("" ::: "memory"); }
    }
    __device__ __forceinline__ void operator()(const f32x4 (&acc)[2][2][4][2], const Unit& u, int wr, int wc, int fr, int fq) const {
        const int pn = u.pn, rowb = u.pm * BM + wr * 64 + fr, cw = wc * 32 + fq * 8;
        if (pn < 12) { bf16_t* dst = (bf16_t*)(ws + WS_SBQ + (size_t)(DBG_SWAP(pn >> 2)) * (32u << 20)); plain<1024, false>(acc, dst + (pn & 3) * BM + cw, nullptr, rowb, fq, pn < 4 ? SBQ_SCALE : 1.0f);
        } else if (pn < 15) { plain<768, true, 12>(acc, (bf16_t*)(ws + WS_CQ) + (pn - 12) * BM + cw, ssq_q + (pn - 12) * 4 + wc, rowb, fq, 1.0f);
        } else if (pn < 17) { plain<512, true, 8>(acc, (bf16_t*)(ws + WS_CKV) + (pn - 15) * BM + cw, ssq_kv + (pn - 15) * 4 + wc, rowb, fq, 1.0f);
        } else if (pn < 33) {
            bf16_t* dst = (bf16_t*)(ws + WS_GSB + (size_t)((pn - 17) >> 3) * (64u << 20)); const int ct = (pn - 17) & 7; const float* bp = bgate + (pn - 17) * BM + cw;
            f32x4 bv[2][2];
#pragma unroll
            for (int bj = 0; bj < 2; ++bj)
#pragma unroll
#ifdef DBG_NOBIAS
                for (int n = 0; n < 2; ++n) bv[bj][n] = (f32x4){0.f, 0.f, 0.f, 0.f};
#else
                for (int n = 0; n < 2; ++n) bv[bj][n] = *(const f32x4*)(bp + bj * HALF + 4 * n);
#endif
#pragma unroll
            for (int ai = 0; ai < 2; ++ai)
#pragma unroll
                for (int m = 0; m < 4; ++m) { const int row = rowb + ai * HALF + m * 16;
#pragma unroll
                    for (int bj = 0; bj < 2; ++bj) { f32x4 v0 = acc[ai][bj][m][0] + bv[bj][0], v1 = acc[ai][bj][m][1] + bv[bj][1];
#pragma unroll
                        for (int e = 0; e < 4; ++e) { v0[e] = sigmoidf_(v0[e]); v1[e] = sigmoidf_(v1[e]); }
                        *(u32x4*)(dst + (size_t)row * 2048 + ct * BM + bj * HALF + cw) = pack8(v0, v1); }
                    asm volatile("" ::: "memory"); }
        } else {
            if (wc < 2) {
#pragma unroll
                for (int ai = 0; ai < 2; ++ai)
#pragma unroll
                    for (int m = 0; m < 4; ++m) { const int row = rowb + ai * HALF + m * 16; const f32x2* rp = (const f32x2*)(ws + WS_ROPE) + (size_t)(row & 4095) * 32 + (cw >> 1);
                        f32x4 v0 = acc[ai][0][m][0], v1 = acc[ai][0][m][1];
                        const f32x2 c0 = rp[0], c1 = rp[1], c2 = rp[2], c3 = rp[3];
                        f32x4 o0, o1;
                        o0[0] = v0[0] * c0.x - v0[1] * c0.y; o0[1] = v0[0] * c0.y + v0[1] * c0.x; o0[2] = v0[2] * c1.x - v0[3] * c1.y; o0[3] = v0[2] * c1.y + v0[3] * c1.x;
                        o1[0] = v1[0] * c2.x - v1[1] * c2.y; o1[1] = v1[0] * c2.y + v1[1] * c2.x; o1[2] = v1[2] * c3.x - v1[3] * c3.y; o1[3] = v1[2] * c3.y + v1[3] * c3.x;
                        *(u32x4*)((bf16_t*)(ws + WS_KR) + (size_t)row * 64 + cw) = pack8(o0, o1); asm volatile("" ::: "memory"); }
            }
        }
    }
};

struct EpiQUp {
    static constexpr bool PERM = true, AFTER_DRAIN = false, APERM = false;
    bf16_t* out; const float* ssq; const f32x2* rope;
    __device__ __forceinline__ void operator()(const f32x4 (&acc)[2][2][4][2], const Unit& u, int wr, int wc, int fr, int fq) const {
        const int rowb = u.pm * BM + wr * 64 + fr, cw = wc * 32 + fq * 8;
#pragma unroll
        for (int ai = 0; ai < 2; ++ai)
#pragma unroll
            for (int m = 0; m < 4; ++m) { const int row = rowb + ai * HALF + m * 16; const f32x4 s0 = *(const f32x4*)(ssq + (size_t)row * 12), s1 = *(const f32x4*)(ssq + (size_t)row * 12 + 4), s2 = *(const f32x4*)(ssq + (size_t)row * 12 + 8);
                const float sst = (((s0[0] + s0[1]) + (s0[2] + s0[3])) + ((s1[0] + s1[1]) + (s1[2] + s1[3]))) + ((s2[0] + s2[1]) + (s2[2] + s2[3]));
                const float rs = __builtin_amdgcn_rsqf(sst * (1.0f / 768.0f) + EPS_) * MLAQ_SCALE;
#pragma unroll
                for (int bj = 0; bj < 2; ++bj) { const int c = u.pn * BM + bj * HALF + cw, within = c % 192;
                    f32x4 v0 = acc[ai][bj][m][0] * rs, v1 = acc[ai][bj][m][1] * rs;
                    if (within >= 128) { const f32x2* rp = rope + (size_t)(row & 4095) * 32 + ((within - 128) >> 1);
                        const f32x2 c0 = rp[0], c1 = rp[1], c2 = rp[2], c3 = rp[3]; f32x4 o0, o1;
                        o0[0] = v0[0] * c0.x - v0[1] * c0.y; o0[1] = v0[0] * c0.y + v0[1] * c0.x; o0[2] = v0[2] * c1.x - v0[3] * c1.y; o0[3] = v0[2] * c1.y + v0[3] * c1.x;
                        o1[0] = v1[0] * c2.x - v1[1] * c2.y; o1[1] = v1[0] * c2.y + v1[1] * c2.x; o1[2] = v1[2] * c3.x - v1[3] * c3.y; o1[3] = v1[2] * c3.y + v1[3] * c3.x;
                        v0 = o0; v1 = o1; }
                    *(u32x4*)(out + (size_t)row * 1536 + c) = pack8(v0, v1); }
                asm volatile("" ::: "memory"); }
    }
};
struct EpiKvUp {
    static constexpr bool PERM = true, AFTER_DRAIN = false, APERM = false;
    bf16_t* out; const float* ssq;
    __device__ __forceinline__ void operator()(const f32x4 (&acc)[2][2][4][2], const Unit& u, int wr, int wc, int fr, int fq) const {
        const int rowb = u.pm * BM + wr * 64 + fr, cw = wc * 32 + fq * 8;
#pragma unroll
        for (int ai = 0; ai < 2; ++ai)
#pragma unroll
            for (int m = 0; m < 4; ++m) { const int row = rowb + ai * HALF + m * 16; const f32x4 s0 = *(const f32x4*)(ssq + (size_t)row * 8), s1 = *(const f32x4*)(ssq + (size_t)row * 8 + 4);
                const float sst = ((s0[0] + s0[1]) + (s0[2] + s0[3])) + ((s1[0] + s1[1]) + (s1[2] + s1[3]));
                const float rs = __builtin_amdgcn_rsqf(sst * (1.0f / 512.0f) + EPS_);
#pragma unroll
                for (int bj = 0; bj < 2; ++bj) *(u32x4*)(out + (size_t)row * 2048 + u.pn * BM + bj * HALF + cw) = pack8(acc[ai][bj][m][0] * rs, acc[ai][bj][m][1] * rs); }
    }
};
struct EpiPlain {
    static constexpr bool PERM = true, AFTER_DRAIN = false, APERM = false;
    bf16_t* out; int ldc;
    __device__ __forceinline__ void operator()(const f32x4 (&acc)[2][2][4][2], const Unit& u, int wr, int wc, int fr, int fq) const {
        const int rowb = u.pm * BM + wr * 64 + fr, cw = wc * 32 + fq * 8;
#pragma unroll
        for (int ai = 0; ai < 2; ++ai)
#pragma unroll
            for (int m = 0; m < 4; ++m) { const int row = rowb + ai * HALF + m * 16;
#pragma unroll
                for (int bj = 0; bj < 2; ++bj) *(u32x4*)(out + (size_t)row * ldc + u.pn * BM + bj * HALF + cw) = pack8(acc[ai][bj][m][0], acc[ai][bj][m][1]); }
    }
};
template <bool FIRST> struct EpiGate {
    static constexpr bool PERM = true, AFTER_DRAIN = false, APERM = false;
    const bf16_t* gate; float* part; bf16_t* out;
    __device__ __forceinline__ void operator()(const f32x4 (&acc)[2][2][4][2], const Unit& u, int wr, int wc, int fr, int fq) const {
        const int rowb = u.pm * BM + wr * 64 + fr, cw = wc * 32 + fq * 8;
#pragma unroll
        for (int ai = 0; ai < 2; ++ai)
#pragma unroll
            for (int m = 0; m < 4; ++m) { const int row = rowb + ai * HALF + m * 16;
#pragma unroll
                for (int bj = 0; bj < 2; ++bj) { const size_t off = (size_t)row * 2048 + u.pn * BM + bj * HALF + cw;
                    const u32x4 g = *(const u32x4*)(gate + off);
                    f32x4 v0 = acc[ai][bj][m][0], v1 = acc[ai][bj][m][1];
                    v0[0] *= bf_lo(g.x); v0[1] *= bf_hi(g.x); v0[2] *= bf_lo(g.y); v0[3] *= bf_hi(g.y); v1[0] *= bf_lo(g.z); v1[1] *= bf_hi(g.z); v1[2] *= bf_lo(g.w); v1[3] *= bf_hi(g.w);
#ifdef SKIP_SB
                    if (FIRST) { v0 *= 0.f; v1 *= 0.f; }
#endif
#ifdef SKIP_MLA
                    if (!FIRST) { v0 *= 0.f; v1 *= 0.f; }
#endif
                    bf16_t* pb = (bf16_t*)part;
                    if (FIRST) { *(u32x4*)(pb + off) = pack8(v0, v1); }
                    else { const u32x4 q = *(const u32x4*)(pb + off);
                        v0[0] += bf_lo(q.x); v0[1] += bf_hi(q.x); v0[2] += bf_lo(q.y); v0[3] += bf_hi(q.y); v1[0] += bf_lo(q.z); v1[1] += bf_hi(q.z); v1[2] += bf_lo(q.w); v1[3] += bf_hi(q.w);
                        *(u32x4*)(out + off) = pack8(v0, v1); } } }
    }
};
struct EpiResid {
    static constexpr bool PERM = true, AFTER_DRAIN = false, APERM = false;
    const float* base; float* out;
    __device__ __forceinline__ void operator()(const f32x4 (&acc)[2][2][4][2], const Unit& u, int wr, int wc, int fr, int fq) const {
        const int rowb = u.pm * BM + wr * 64 + fr, cw = wc * 32 + fq * 8;
#pragma unroll
        for (int ai = 0; ai < 2; ++ai)
#pragma unroll
            for (int m = 0; m < 4; ++m) { const int row = rowb + ai * HALF + m * 16;
#pragma unroll
                for (int bj = 0; bj < 2; ++bj) { const size_t off = (size_t)row * 2048 + u.pn * BM + bj * HALF + cw;
                    *(f32x4*)(out + off) = *(const f32x4*)(base + off) + acc[ai][bj][m][0]; *(f32x4*)(out + off + 4) = *(const f32x4*)(base + off + 4) + acc[ai][bj][m][1]; } }
    }
};

struct EpiResidStat {
    static constexpr bool PERM = true, AFTER_DRAIN = false, APERM = false;
    const float* base; float* out; bf16_t* hb; float* slots;
    __device__ __forceinline__ void operator()(const f32x4 (&acc)[2][2][4][2], const Unit& u, int wr, int wc, int fr, int fq) const {
        const int rowb = u.pm * BM + wr * 64 + fr, cw = wc * 32 + fq * 8;
#pragma unroll
        for (int ai = 0; ai < 2; ++ai)
#pragma unroll
            for (int m = 0; m < 4; ++m) { const int row = rowb + ai * HALF + m * 16; float ss = 0.f;
#pragma unroll
                for (int bj = 0; bj < 2; ++bj) { const size_t off = (size_t)row * 2048 + u.pn * BM + bj * HALF + cw;
                    const f32x4 v0 = *(const f32x4*)(base + off) + acc[ai][bj][m][0], v1 = *(const f32x4*)(base + off + 4) + acc[ai][bj][m][1];
                    *(f32x4*)(out + off) = v0; *(f32x4*)(out + off + 4) = v1; *(u32x4*)(hb + off) = pack8(v0, v1);
                    ss += (v0[0] * v0[0] + v0[1] * v0[1]) + (v0[2] * v0[2] + v0[3] * v0[3]) + (v1[0] * v1[0] + v1[1] * v1[1]) + (v1[2] * v1[2] + v1[3] * v1[3]); }
                ss = xsum16(ss); ss = xsum32(ss); if (fq == 0) slots[(size_t)row * 32 + u.pn * 4 + wc] = ss;
                asm volatile("" ::: "memory"); }
    }
};
struct EpiPlainScaled {
    static constexpr bool PERM = true, AFTER_DRAIN = false, APERM = false;
    bf16_t* out; int ldc; const float* rstd;
    __device__ __forceinline__ void operator()(const f32x4 (&acc)[2][2][4][2], const Unit& u, int wr, int wc, int fr, int fq) const {
        const int rowb = u.pm * BM + wr * 64 + fr, cw = wc * 32 + fq * 8;
        float rs[2][4];
#pragma unroll
        for (int ai = 0; ai < 2; ++ai)
#pragma unroll
            for (int m = 0; m < 4; ++m) rs[ai][m] = rstd[rowb + ai * HALF + m * 16];
#pragma unroll
        for (int ai = 0; ai < 2; ++ai)
#pragma unroll
            for (int m = 0; m < 4; ++m) { const int row = rowb + ai * HALF + m * 16;
#pragma unroll
                for (int bj = 0; bj < 2; ++bj) *(u32x4*)(out + (size_t)row * ldc + u.pn * BM + bj * HALF + cw) = pack8(acc[ai][bj][m][0] * rs[ai][m], acc[ai][bj][m][1] * rs[ai][m]); }
    }
};

struct EpiUpConv {
    static constexpr bool PERM = true, AFTER_DRAIN = false, APERM = true;
    bf16_t* act; const float* rstd; const float* cw; const float* cb; float* yl; float* yf; PG8_LAS float* xl;
    __device__ __forceinline__ void operator()(const f32x4 (&acc)[2][2][4][2], const Unit& u, int wr, int wc, int fr, int fq) const {
        const int row0 = u.pm * BM + wr * 128 + fr * 8, chl = wc * 32 + fq * 8, ch0 = u.pn * 128 + chl;
        float rs[8];
#pragma unroll
        for (int j = 0; j < 8; ++j) rs[j] = rstd[row0 + j];
        PG8_LAS float* xw = xl + (wc * 4 + fq) * 64;
        if (fr == 15) {
            if (wr == 0) {
#pragma unroll
                for (int bj = 0; bj < 2; ++bj)
#pragma unroll
                    for (int n = 0; n < 2; ++n)
#pragma unroll
                        for (int e = 0; e < 4; ++e) { xw[((bj * 2 + n) * 4 + e) * 2 + 0] = acc[1][bj][2][n][e] * rs[6]; xw[((bj * 2 + n) * 4 + e) * 2 + 1] = acc[1][bj][3][n][e] * rs[7]; }
            } else {
#pragma unroll
                for (int bj = 0; bj < 2; ++bj)
#pragma unroll
                    for (int n = 0; n < 2; ++n) { *(f32x4*)(yl + ((size_t)(u.pm * 2 + 0) * 2 + bj) * 5632 + ch0 + 4 * n) = acc[1][bj][2][n] * rs[6]; *(f32x4*)(yl + ((size_t)(u.pm * 2 + 1) * 2 + bj) * 5632 + ch0 + 4 * n) = acc[1][bj][3][n] * rs[7]; }
            }
        }
        if (fr == 0 && wr == 0) {
#pragma unroll
            for (int bj = 0; bj < 2; ++bj)
#pragma unroll
                for (int n = 0; n < 2; ++n) { *(f32x4*)(yf + ((size_t)(u.pm * 2 + 0) * 2 + bj) * 5632 + ch0 + 4 * n) = acc[0][bj][0][n] * rs[0]; *(f32x4*)(yf + ((size_t)(u.pm * 2 + 1) * 2 + bj) * 5632 + ch0 + 4 * n) = acc[0][bj][1][n] * rs[1]; }
        }
        asm volatile("s_waitcnt lgkmcnt(0)" ::: "memory"); __builtin_amdgcn_s_barrier(); asm volatile("" ::: "memory");
#pragma unroll
        for (int n = 0; n < 2; ++n) {
            f32x4 w[2][3], bb[2];
#pragma unroll
            for (int bj = 0; bj < 2; ++bj) { const int c = bj * 5632 + ch0 + 4 * n; bb[bj] = *(const f32x4*)(cb + c);
#pragma unroll
                for (int i = 0; i < 3; ++i) w[bj][i] = *(const f32x4*)(cw + (size_t)i * 11264 + c); }
            f32x4 o[8];
#pragma unroll
            for (int e = 0; e < 4; ++e) {
                float c2[2][8];
#pragma unroll
                for (int bj = 0; bj < 2; ++bj) {
                    float y[8];
#pragma unroll
                    for (int j = 0; j < 8; ++j) y[j] = acc[j >> 2][bj][j & 3][n][e] * rs[j];
                    float x6 = 0.f, x7 = 0.f;
                    if (wr == 1) { x6 = xw[((bj * 2 + n) * 4 + e) * 2 + 0]; x7 = xw[((bj * 2 + n) * 4 + e) * 2 + 1]; }
                    const float p6 = __uint_as_float(__builtin_amdgcn_update_dpp(__float_as_uint(x6), __float_as_uint(y[6]), 0x111, 0xf, 0xf, false));
                    const float p7 = __uint_as_float(__builtin_amdgcn_update_dpp(__float_as_uint(x7), __float_as_uint(y[7]), 0x111, 0xf, 0xf, false));
                    const float w0 = w[bj][0][e], w1 = w[bj][1][e], w2 = w[bj][2][e], b0 = bb[bj][e];
                    c2[bj][0] = b0 + w0 * p6 + w1 * p7 + w2 * y[0];
                    c2[bj][1] = b0 + w0 * p7 + w1 * y[0] + w2 * y[1];
#pragma unroll
                    for (int j = 2; j < 8; ++j) c2[bj][j] = b0 + w0 * y[j - 2] + w1 * y[j - 1] + w2 * y[j];
                }
#pragma unroll
                for (int j = 0; j < 8; ++j) { const float G = c2[0][j]; o[j][e] = G * sigmoidf_(G) * c2[1][j]; }
            }
#pragma unroll
            for (int j = 0; j < 8; ++j) { u32x2_ pk; pk[0] = cvt_pk_bf16(o[j][0], o[j][1]); pk[1] = cvt_pk_bf16(o[j][2], o[j][3]); *(u32x2_*)(act + (size_t)(row0 + j) * 5632 + ch0 + 4 * n) = pk; }
            asm volatile("" ::: "memory");
        }
    }
};
template <class Epi, class Sched, bool ALIGN_EPI = false, bool SP2 = false>
__device__ __forceinline__ void gemm_phase(PG8_LAS unsigned char* lds, const Gemm g, const Sched& S, const Epi& E, const int wave_s) {
    int tid_op; asm volatile("v_mbcnt_lo_u32_b32 %0, -1, 0\n\tv_mbcnt_hi_u32_b32 %0, -1, %0" : "=v"(tid_op)); tid_op += wave_s * 64;
    const int tid = tid_op, wid = __builtin_amdgcn_readfirstlane(tid >> 6), lane = tid & 63, wr = wid >> 2, wc = wid & 3, fr = lane & 15, fq = lane >> 4;
    const int K = g.K, nt = K / BK;
    unsigned voffA[2], voffB[2];
#pragma unroll
    for (int i = 0; i < 2; ++i) { int R, C; stage_rc(tid * 16 + i * 8192, R, C); const int Rb = Epi::PERM ? ((R & ~31) + perm32(R & 31)) : R;
        const int Ra = Epi::APERM ? (128 * (R >> 6) + 8 * (R & 15) + ((R >> 4) & 3)) : R;
        voffA[i] = (unsigned)(Ra * K + C) * 2u; voffB[i] = (unsigned)(Rb * K + C) * 2u; }
    const size_t kstep = (size_t)(BK * 2);
    const size_t hstep = (size_t)HALF * K * 2;
    const size_t hstepA = Epi::APERM ? (size_t)4 * K * 2 : hstep;
    const size_t tstep = 2 * hstep;
    const unsigned ldsw = (unsigned)wid * 1024u;
    const int aoff = lds_byte(wr * 64 + fr, fq * 8), boff = lds_byte(wc * 32 + fr, fq * 8);
#define PG8_SA(b, h) (((b) * 2 + (h)) * HTB)
#define PG8_SB(b, h) ((4 + (b) * 2 + (h)) * HTB)
#define PG8_STAGE(bufoff, gbase, voff) do { _Pragma("unroll") for (int _i = 0; _i < 2; ++_i) \
        __builtin_amdgcn_global_load_lds((const unsigned*)((const char*)(gbase) + (voff)[_i]), (PG8_LAS unsigned*)(lds + (bufoff) + ldsw + _i * 8192), 16, 0, 0); } while (0)
#define PG8_LDA(dst, b, h) do { _Pragma("unroll") for (int m = 0; m < 4; ++m) _Pragma("unroll") for (int k = 0; k < 2; ++k) dst[m][k] = *(const PG8_LAS bf16x8*)(lds + PG8_SA(b, h) + aoff + m * 2048 + k * 1024); } while (0)
#define PG8_LDB(dst, b, h) do { _Pragma("unroll") for (int n = 0; n < 2; ++n) _Pragma("unroll") for (int k = 0; k < 2; ++k) dst[n][k] = *(const PG8_LAS bf16x8*)(lds + PG8_SB(b, h) + boff + n * 2048 + k * 1024); } while (0)
#define PG8_MMA(ai, bj, At, Bt) do { __builtin_amdgcn_s_setprio(1); _Pragma("unroll") for (int m = 0; m < 4; ++m) _Pragma("unroll") for (int n = 0; n < 2; ++n) _Pragma("unroll") for (int k = 0; k < 2; ++k) \
        acc[ai][bj][m][n] = __builtin_amdgcn_mfma_f32_16x16x32_bf16(Bt[n][k], At[m][k], acc[ai][bj][m][n], 0, 0, 0); __builtin_amdgcn_s_setprio(0); } while (0)
#define PG8_WAIT_V(n) asm volatile("s_waitcnt vmcnt(" #n ")" ::: "memory")
#define PG8_WAIT_L(n) asm volatile("s_waitcnt lgkmcnt(" #n ")" ::: "memory")
#define PG8_BAR __builtin_amdgcn_s_barrier()
#define PG8_SCHED __builtin_amdgcn_sched_barrier(0)
    Unit cur, nxt; int ui = 0;
    if (!S.next(0, cur)) return;
    f32x4 acc[2][2][4][2];
#pragma unroll
    for (int a = 0; a < 2; ++a)
#pragma unroll
        for (int b = 0; b < 2; ++b)
#pragma unroll
            for (int m = 0; m < 4; ++m)
#pragma unroll
                for (int n = 0; n < 2; ++n) { float z_ = 0.f; asm volatile("" : "+v"(z_)); acc[a][b][m][n] = (f32x4){z_, z_, z_, z_}; }
    bf16x8 At[4][2], B0[2][2], B1[2][2];
    const char* cA = (const char*)g.A + (size_t)cur.pm * tstep; const char* cB = (const char*)g.Bt + (size_t)cur.pn * tstep;
    S.a_ready(cur);
    if constexpr (SP2) {
        PG8_STAGE(PG8_SB(0, 0), cB, voffB); PG8_STAGE(PG8_SB(0, 1), cB + hstep, voffB); PG8_STAGE(PG8_SA(0, 0), cA, voffA); PG8_STAGE(PG8_SA(0, 1), cA + hstepA, voffA);
        if (wr == 1) PG8_BAR;
        PG8_WAIT_V(2); PG8_BAR;
        PG8_STAGE(PG8_SB(1, 0), cB + kstep, voffB); PG8_STAGE(PG8_SA(1, 0), cA + kstep, voffA); PG8_STAGE(PG8_SB(1, 1), cB + hstep + kstep, voffB);
        PG8_WAIT_V(6); PG8_BAR;
    } else {
        PG8_STAGE(PG8_SB(0, 0), cB, voffB); PG8_STAGE(PG8_SA(0, 0), cA, voffA); PG8_STAGE(PG8_SB(0, 1), cB + hstep, voffB); PG8_STAGE(PG8_SA(0, 1), cA + hstepA, voffA);
        if (wr == 1) PG8_BAR;
        PG8_WAIT_V(4); PG8_BAR;
        PG8_STAGE(PG8_SB(1, 0), cB + kstep, voffB); PG8_STAGE(PG8_SA(1, 0), cA + kstep, voffA); PG8_STAGE(PG8_SB(1, 1), cB + hstep + kstep, voffB);
        PG8_WAIT_V(6); PG8_BAR;
    }
    for (;;) {
        const bool has_next = S.next(ui + 1, nxt);
        const char* nA = has_next ? (const char*)g.A + (size_t)nxt.pm * tstep : cA; const char* nB = has_next ? (const char*)g.Bt + (size_t)nxt.pn * tstep : cB;
        for (int t = 0; t < nt; t += 2) {
            const bool last = (t == nt - 2);
            const char* a1 = cA + (size_t)(t + 1) * kstep;
            const char* a2 = last ? nA : cA + (size_t)(t + 2) * kstep; const char* b2 = last ? nB : cB + (size_t)(t + 2) * kstep;
            const char* a3 = a2 + kstep; const char* b3 = b2 + kstep;
            if (last && has_next) S.a_ready(nxt);
            if constexpr (SP2) {
            PG8_LDB(B0, 0, 0); PG8_LDB(B1, 0, 1); PG8_SCHED; PG8_LDA(At, 0, 0); PG8_STAGE(PG8_SA(1, 1), a1 + hstepA, voffA);
            PG8_WAIT_V(8); PG8_WAIT_L(0); PG8_BAR; PG8_MMA(0, 0, At, B0); PG8_MMA(0, 1, At, B1); PG8_BAR; PG8_SCHED;
            PG8_LDA(At, 0, 1); PG8_STAGE(PG8_SB(0, 0), b2, voffB); PG8_STAGE(PG8_SB(0, 1), b2 + hstep, voffB); PG8_STAGE(PG8_SA(0, 0), a2, voffA);
            PG8_WAIT_V(8); PG8_WAIT_L(0); PG8_BAR; PG8_MMA(1, 0, At, B0); PG8_MMA(1, 1, At, B1); PG8_BAR; PG8_SCHED;
            PG8_LDB(B0, 1, 0); PG8_LDB(B1, 1, 1); PG8_SCHED; PG8_LDA(At, 1, 0); PG8_STAGE(PG8_SA(0, 1), a2 + hstepA, voffA);
            PG8_WAIT_V(8); PG8_WAIT_L(0); PG8_BAR; PG8_MMA(0, 0, At, B0); PG8_MMA(0, 1, At, B1); PG8_BAR; PG8_SCHED;
            PG8_LDA(At, 1, 1); PG8_STAGE(PG8_SB(1, 0), b3, voffB); PG8_STAGE(PG8_SB(1, 1), b3 + hstep, voffB); PG8_STAGE(PG8_SA(1, 0), a3, voffA);
            PG8_WAIT_V(8); PG8_WAIT_L(0); PG8_BAR; PG8_MMA(1, 0, At, B0); PG8_MMA(1, 1, At, B1); PG8_BAR; PG8_SCHED;
            } else {
            PG8_LDB(B0, 0, 0); PG8_SCHED; PG8_LDA(At, 0, 0); PG8_STAGE(PG8_SA(1, 1), a1 + hstepA, voffA);
            PG8_WAIT_L(8); PG8_BAR; PG8_WAIT_L(0); PG8_MMA(0, 0, At, B0); PG8_BAR; PG8_SCHED;
            PG8_LDB(B1, 0, 1); PG8_STAGE(PG8_SB(0, 0), b2, voffB);
            PG8_BAR; PG8_WAIT_L(0); PG8_MMA(0, 1, At, B1); PG8_BAR;
            PG8_LDA(At, 0, 1); PG8_STAGE(PG8_SA(0, 0), a2, voffA);
            PG8_BAR; PG8_WAIT_L(0); PG8_MMA(1, 0, At, B0); PG8_BAR; PG8_SCHED;
            PG8_STAGE(PG8_SB(0, 1), b2 + hstep, voffB);
            PG8_WAIT_V(6); PG8_BAR; PG8_MMA(1, 1, At, B1); PG8_BAR;
            PG8_LDB(B0, 1, 0); PG8_SCHED; PG8_LDA(At, 1, 0); PG8_STAGE(PG8_SA(0, 1), a2 + hstepA, voffA);
            PG8_WAIT_L(8); PG8_BAR; PG8_WAIT_L(0); PG8_MMA(0, 0, At, B0); PG8_BAR; PG8_SCHED;
            PG8_LDB(B1, 1, 1); PG8_STAGE(PG8_SB(1, 0), b3, voffB);
            PG8_BAR; PG8_WAIT_L(0); PG8_MMA(0, 1, At, B1); PG8_BAR;
            PG8_LDA(At, 1, 1); PG8_STAGE(PG8_SA(1, 0), a3, voffA);
            PG8_BAR; PG8_WAIT_L(0); PG8_MMA(1, 0, At, B0); PG8_BAR; PG8_SCHED;
            PG8_STAGE(PG8_SB(1, 1), b3 + hstep, voffB);
            PG8_WAIT_V(6); PG8_BAR; PG8_MMA(1, 1, At, B1); PG8_BAR;
            }
        }
        if constexpr (ALIGN_EPI) { if (wr == 0) PG8_BAR; }
        if constexpr (!Epi::AFTER_DRAIN) { E(acc, cur, wr, wc, fr, fq); S.done(cur); }
        if (!has_next) break;
#pragma unroll
        for (int a = 0; a < 2; ++a)
#pragma unroll
            for (int b = 0; b < 2; ++b)
#pragma unroll
                for (int m = 0; m < 4; ++m)
#pragma unroll
                    for (int n = 0; n < 2; ++n) { float z_ = 0.f; asm volatile("" : "+v"(z_)); acc[a][b][m][n] = (f32x4){z_, z_, z_, z_}; }
        cur = nxt; cA = nA; cB = nB; ++ui;
        if constexpr (ALIGN_EPI) { if (wr == 1) PG8_BAR; }
    }
    PG8_WAIT_V(0);
    if constexpr (!ALIGN_EPI) { if (wr == 0) PG8_BAR; }
    PG8_BAR;
    if constexpr (Epi::AFTER_DRAIN) { E.fused(acc, cur, wr, wc, fr, fq, lds, wid, lane); S.done(cur); }
#undef PG8_SA
#undef PG8_SB
#undef PG8_STAGE
#undef PG8_LDA
#undef PG8_LDB
#undef PG8_MMA
#undef PG8_WAIT_V
#undef PG8_WAIT_L
#undef PG8_BAR
#undef PG8_SCHED
}
}
#define GAS __attribute__((address_space(1)))
#define LAS __attribute__((address_space(3)))
typedef unsigned short bf16;
typedef unsigned v4u __attribute__((ext_vector_type(4)));
typedef unsigned v2u __attribute__((ext_vector_type(2)));
typedef float f32x4 __attribute__((ext_vector_type(4)));
typedef float f32x2 __attribute__((ext_vector_type(2)));
typedef float f32x16 __attribute__((ext_vector_type(16)));
typedef short bf16x8 __attribute__((ext_vector_type(8)));
typedef short s16x4 __attribute__((ext_vector_type(4)));
#define LDS_WAIT() asm volatile("s_waitcnt lgkmcnt(0)" ::: "memory")

constexpr int LDS_BYTES = 147456;

__device__ __forceinline__ unsigned f2bf(float f) { unsigned u = __builtin_bit_cast(unsigned, f); return (u + 0x7fffu + ((u >> 16) & 1u)) >> 16; }
__device__ __forceinline__ unsigned pk2(float lo, float hi) { return pg8::cvt_pk_bf16(lo, hi); }
__device__ __forceinline__ float wave_sum(float v) { return pg8::wave_sum_(v); }
__device__ __forceinline__ int crow(int r, int hi) { return (r & 3) + 8 * (r >> 2) + 4 * hi; }

__device__ __forceinline__ int rowmap(int mode, int n) {
    if (mode == 1) {
#ifdef DBG_SWAPW
        if (n >= 1024 && n < 3072) return n < 2048 ? n + 1024 : n - 1024;
#endif
        if (n < 4352) return n; if (n < 4416) { const int i = n - 4352; return 8448 + (i < 32 ? 2 * i : 2 * (i - 32) + 1); } return n - 64; }
    if (mode == 2) { const int hh = n / 192, c = n - hh * 192; if (c < 128) return n; const int i = c - 128; return hh * 192 + 128 + (i < 32 ? 2 * i : 2 * (i - 32) + 1); }
    if (mode == 3) { if (n < DFF) return (n >> 7) * 256 + (n & 127); const int n2 = n - DFF; return (n2 >> 7) * 256 + 128 + (n2 & 127); }
    return n;
}
__device__ __forceinline__ void conv_item(const float* W, int K, int N, bf16* WT, int mode, const float* ksc, LAS float* scr, int item, int lane) {
    const int nblk = N / 64, kb = item / nblk, nb = item - kb * nblk, k0 = 64 * kb, n0 = 64 * nb;
#pragma unroll 8
    for (int i = 0; i < 16; ++i) { const int kk = 4 * i + (lane >> 4); const f32x4 v = *(const f32x4*)(W + (size_t)(k0 + kk) * N + n0 + 4 * (lane & 15)); const float s = ksc ? ksc[k0 + kk] : 1.0f;
        LAS float* d = scr + kk * 65 + 4 * (lane & 15); d[0] = v[0] * s; d[1] = v[1] * s; d[2] = v[2] * s; d[3] = v[3] * s; }
    LDS_WAIT();
    const int c = lane & 7;
#pragma unroll
    for (int j = 0; j < 8; ++j) { const int n = (lane >> 3) + 8 * j; const LAS float* s = scr + (8 * c) * 65 + n;
        v4u o; o.x = pk2(s[0 * 65], s[1 * 65]); o.y = pk2(s[2 * 65], s[3 * 65]); o.z = pk2(s[4 * 65], s[5 * 65]); o.w = pk2(s[6 * 65], s[7 * 65]);
        *(v4u*)(WT + (size_t)rowmap(mode, n0 + n) * K + k0 + 8 * c) = o; }
    LDS_WAIT();
}

struct Args {
    const float* in[17]; float* out; unsigned char* ws; int ph_lo, ph_hi;
};

__device__ __forceinline__ void norm_rows(const float* X, const float* g, bf16* outb, float* outf, int gw, int NGW, int lane) {
    for (int m = gw; m < T_; m += NGW) {
        const f32x4* xr = (const f32x4*)(X + (size_t)m * DM) + lane; f32x4 v[8]; float ss = 0.f;
#pragma unroll
        for (int j = 0; j < 8; ++j) { v[j] = xr[64 * j]; ss += (v[j][0] * v[j][0] + v[j][1] * v[j][1]) + (v[j][2] * v[j][2] + v[j][3] * v[j][3]); }
        const float rstd = 1.0f / sqrtf(wave_sum(ss) * (1.0f / DM) + 1e-6f);
#pragma unroll
        for (int j = 0; j < 8; ++j) { const f32x4 gv = ((const f32x4*)g)[lane + 64 * j]; const f32x4 o = v[j] * rstd * gv;
            if (outb) { v2u w; w.x = pk2(o[0], o[1]); w.y = pk2(o[2], o[3]); *(v2u*)(outb + (size_t)m * DM + 4 * (lane + 64 * j)) = w; }
            else *((f32x4*)(outf + (size_t)m * DM) + lane + 64 * j) = o; }
    }
}

__device__ __forceinline__ void unpack8(const v4u w, float (&f)[8]) { f[0] = pg8::bf_lo(w.x); f[1] = pg8::bf_hi(w.x); f[2] = pg8::bf_lo(w.y); f[3] = pg8::bf_hi(w.y); f[4] = pg8::bf_lo(w.z); f[5] = pg8::bf_hi(w.z); f[6] = pg8::bf_lo(w.w); f[7] = pg8::bf_hi(w.w); }
__device__ __forceinline__ void conv_act_half(const bf16* Y, bf16* ACT, const float* cw, const float* cb, int gtid, int NT) {
    constexpr int NCG = DFF / 8, NRB = 8192 / 32;
    for (int idx = gtid; idx < NCG * NRB; idx += NT) {
        const int rb = idx / NCG, cgi = idx - rb * NCG, c0 = 8 * cgi, vg = (c0 >> 7) * 256 + (c0 & 127), vv = vg + 128;
        float wg[3][8], wv[3][8], bg[8], bv[8];
#pragma unroll
        for (int i = 0; i < 3; ++i)
#pragma unroll
            for (int e = 0; e < 8; ++e) { wg[i][e] = cw[(size_t)i * 2 * DFF + c0 + e]; wv[i][e] = cw[(size_t)i * 2 * DFF + DFF + c0 + e]; }
#pragma unroll
        for (int e = 0; e < 8; ++e) { bg[e] = cb[c0 + e]; bv[e] = cb[DFF + c0 + e]; }
        const int r0 = rb * 32;
        float g2[8], g1[8], v2[8], v1[8];
        if ((r0 & (SEQ_ - 1)) == 0) {
#pragma unroll
            for (int e = 0; e < 8; ++e) { g2[e] = 0.f; g1[e] = 0.f; v2[e] = 0.f; v1[e] = 0.f; }
        } else {
            unpack8(*(const v4u*)(Y + (size_t)(r0 - 2) * (2 * DFF) + vg), g2); unpack8(*(const v4u*)(Y + (size_t)(r0 - 1) * (2 * DFF) + vg), g1);
            unpack8(*(const v4u*)(Y + (size_t)(r0 - 2) * (2 * DFF) + vv), v2); unpack8(*(const v4u*)(Y + (size_t)(r0 - 1) * (2 * DFF) + vv), v1);
        }
#pragma unroll 8
        for (int k = 0; k < 32; ++k) { const int r = r0 + k; float g0[8], v0[8], o[8];
            unpack8(*(const v4u*)(Y + (size_t)r * (2 * DFF) + vg), g0); unpack8(*(const v4u*)(Y + (size_t)r * (2 * DFF) + vv), v0);
#pragma unroll
            for (int e = 0; e < 8; ++e) { const float G = bg[e] + wg[0][e] * g2[e] + wg[1][e] * g1[e] + wg[2][e] * g0[e], V = bv[e] + wv[0][e] * v2[e] + wv[1][e] * v1[e] + wv[2][e] * v0[e];
                o[e] = G * pg8::sigmoidf_(G) * V; g2[e] = g1[e]; g1[e] = g0[e]; v2[e] = v1[e]; v1[e] = v0[e]; }
            v4u w; w.x = pk2(o[0], o[1]); w.y = pk2(o[2], o[3]); w.z = pk2(o[4], o[5]); w.w = pk2(o[6], o[7]);
            *(v4u*)(ACT + (size_t)r * DFF + c0) = w; }
    }
}

__device__ __forceinline__ s16x4 vtr(const LAS unsigned char* p) { return __builtin_bit_cast(s16x4, __builtin_amdgcn_ds_read_tr16_b64_v4i16((LAS s16x4*)p)); }
#define MFMA32(a, b, c) __builtin_amdgcn_mfma_f32_32x32x16_bf16((a), (b), (c), 0, 0, 0)

__device__ __forceinline__ void sb_unit(const bf16* Q, const bf16* K, const bf16* V, bf16* O, int b, int h, int qb, LAS unsigned char* lds, const int wave_s, const bool do_store = true) {
    int tid_op; asm volatile("v_mbcnt_lo_u32_b32 %0, -1, 0\n\tv_mbcnt_hi_u32_b32 %0, -1, %0" : "=v"(tid_op)); tid_op += wave_s * 64;
    const int tid = tid_op, lane = tid & 63, r32 = lane & 31, hi = lane >> 5, wid = __builtin_amdgcn_readfirstlane(tid >> 6);
    LAS unsigned char* vl = lds + wid * 10240;
    const int q0 = qb * 256 + wid * 32; const size_t rowbase = (size_t)b * SEQ_;
    const bf16* Qp = Q + (rowbase + q0 + r32) * 1024 + h * 128 + hi * 8;
    bf16x8 qf[8];
#pragma unroll
    for (int kk = 0; kk < 8; ++kk) qf[kk] = *(const bf16x8*)(Qp + 16 * kk);
    f32x16 o[4];
#pragma unroll
    for (int d = 0; d < 4; ++d)
#pragma unroll
        for (int r = 0; r < 16; ++r) o[d][r] = 0.f;
    float carry = 0.f;
    const int trofs = (4 * hi + ((lane & 15) >> 2)) * 320 + (((lane >> 4) & 1) * 16 + (lane & 3) * 4) * 2;
    for (int kb = q0; kb >= 0; kb -= 32) {
        const bf16* Kp = K + (rowbase + kb + r32) * 1024 + h * 128 + hi * 8;
        bf16x8 kf[8];
#pragma unroll
        for (int kk = 0; kk < 8; ++kk) kf[kk] = *(const bf16x8*)(Kp + 16 * kk);
        v4u vv[8];
#pragma unroll
        for (int i = 0; i < 8; ++i) { const int c = i * 64 + lane, row = c >> 4, ch = c & 15; vv[i] = *(const v4u*)(V + (rowbase + kb + row) * 1024 + h * 128 + ch * 8); }
        f32x16 p;
#pragma unroll
        for (int r = 0; r < 16; ++r) p[r] = 0.f;
#pragma unroll
        for (int kk = 0; kk < 8; ++kk) p = MFMA32(kf[kk], qf[kk], p);
        LDS_WAIT();
#pragma unroll
        for (int i = 0; i < 8; ++i) { const int c = i * 64 + lane, row = c >> 4, ch = c & 15; *(LAS v4u*)(vl + row * 320 + ch * 16) = vv[i]; }
        const bool diag = (kb == q0);
        float lf[16], ls[16];
#pragma unroll
        for (int r = 0; r < 16; ++r) { const float z = p[r], e = __builtin_amdgcn_exp2f(-fabsf(z)), L = __builtin_amdgcn_logf(1.0f + e);
            lf[r] = -(fmaxf(z, 0.f) + L); ls[r] = fminf(z, 0.f) - L;
            if (diag && !(crow(r, hi) < r32)) { lf[r] = 0.f; ls[r] = -INFINITY; } }
        float G[4], Go[4];
#pragma unroll
        for (int g = 0; g < 4; ++g) { G[g] = (lf[4 * g] + lf[4 * g + 1]) + (lf[4 * g + 2] + lf[4 * g + 3]); Go[g] = pg8::xother32(G[g], hi); }
        float Tg[4]; Tg[3] = 0.f; Tg[2] = G[3] + Go[3]; Tg[1] = Tg[2] + (G[2] + Go[2]); Tg[0] = Tg[1] + (G[1] + Go[1]);
        const float total = Tg[0] + (G[0] + Go[0]);
        float a[16];
#pragma unroll
        for (int g = 0; g < 4; ++g) { const float base = carry + Tg[g] + (hi == 0 ? Go[g] : 0.f);
            const float s3 = base, s2 = s3 + lf[4 * g + 3], s1 = s2 + lf[4 * g + 2], s0 = s1 + lf[4 * g + 1];
            a[4 * g + 3] = __builtin_amdgcn_exp2f(ls[4 * g + 3] + s3); a[4 * g + 2] = __builtin_amdgcn_exp2f(ls[4 * g + 2] + s2);
            a[4 * g + 1] = __builtin_amdgcn_exp2f(ls[4 * g + 1] + s1); a[4 * g + 0] = __builtin_amdgcn_exp2f(ls[4 * g + 0] + s0); }
        carry += total;
        bf16x8 pw[2];
#pragma unroll
        for (int s = 0; s < 2; ++s) { v4u w; w.x = pk2(a[8 * s], a[8 * s + 1]); w.y = pk2(a[8 * s + 2], a[8 * s + 3]); w.z = pk2(a[8 * s + 4], a[8 * s + 5]); w.w = pk2(a[8 * s + 6], a[8 * s + 7]); pw[s] = __builtin_bit_cast(bf16x8, w); }
        LDS_WAIT();
#pragma unroll
        for (int db = 0; db < 4; ++db)
#pragma unroll
            for (int s = 0; s < 2; ++s) { const s16x4 lo = vtr(vl + trofs + (16 * s) * 320 + db * 64), hh = vtr(vl + trofs + (16 * s + 8) * 320 + db * 64);
                const bf16x8 A = (bf16x8){lo[0], lo[1], lo[2], lo[3], hh[0], hh[1], hh[2], hh[3]};
                o[db] = MFMA32(A, pw[s], o[db]); if (s == 1) __builtin_amdgcn_sched_barrier(0); }
        if (__all(carry < -160.0f)) break;
    }
    bf16* Op = O + (rowbase + q0 + r32) * 1024 + h * 128 + 4 * hi;
    if (do_store) {
#pragma unroll
    for (int db = 0; db < 4; ++db)
#pragma unroll
        for (int g = 0; g < 4; ++g) { v2u w; w.x = pk2(o[db][4 * g], o[db][4 * g + 1]); w.y = pk2(o[db][4 * g + 2], o[db][4 * g + 3]); *(v2u*)(Op + 32 * db + 8 * g) = w; }
    } else { float acc_ = 0.f;
#pragma unroll
      for (int db = 0; db < 4; ++db)
#pragma unroll
        for (int g = 0; g < 16; ++g) acc_ += o[db][g];
      if (acc_ == 1.2345e33f) Op[0] = 0; }
    LDS_WAIT();
}

constexpr int MLA_KB = 64 * 400, MLA_VB = 64 * 320, MLA_BUF = MLA_KB + MLA_VB;
__device__ __forceinline__ void mla_unit(const bf16* QM, const bf16* KV, const bf16* KR, bf16* O, int b, int h, int qb, LAS unsigned char* lds, const int wave_s) {
    int tid_op; asm volatile("v_mbcnt_lo_u32_b32 %0, -1, 0\n\tv_mbcnt_hi_u32_b32 %0, -1, %0" : "=v"(tid_op)); tid_op += wave_s * 64;
    const int tid = tid_op, lane = tid & 63, r32 = lane & 31, hi = lane >> 5, wid = __builtin_amdgcn_readfirstlane(tid >> 6);
    const int q0 = qb * 256 + wid * 32; const size_t rowbase = (size_t)b * SEQ_;
    const int NT = 4 * qb + 4, ntw = 4 * qb + (wid >> 1) + 1;
    const bf16* Qp = QM + (rowbase + q0 + r32) * 1536 + h * 192 + hi * 8;
    bf16x8 qf[12];
#pragma unroll
    for (int kk = 0; kk < 12; ++kk) qf[kk] = *(const bf16x8*)(Qp + 16 * kk);
    int krow[3], kch[3], vrow[2], vch[2];
#pragma unroll
    for (int i = 0; i < 3; ++i) { const int c = tid + 512 * i; krow[i] = c / 24; kch[i] = c - krow[i] * 24; }
#pragma unroll
    for (int i = 0; i < 2; ++i) { const int c = tid + 512 * i; vrow[i] = c >> 4; vch[i] = c & 15; }
    v4u kreg[3], vreg[2];
#define MLA_LOAD(t) do { \
    _Pragma("unroll") for (int i = 0; i < 3; ++i) { const size_t kr_ = rowbase + 64 * (t) + krow[i]; \
        kreg[i] = kch[i] < 16 ? *(const v4u*)(KV + kr_ * 2048 + h * 256 + kch[i] * 8) : *(const v4u*)(KR + kr_ * 64 + (kch[i] - 16) * 8); } \
    _Pragma("unroll") for (int i = 0; i < 2; ++i) { const size_t kr_ = rowbase + 64 * (t) + vrow[i]; vreg[i] = *(const v4u*)(KV + kr_ * 2048 + h * 256 + 128 + vch[i] * 8); } } while (0)
#define MLA_STORE(buf) do { \
    _Pragma("unroll") for (int i = 0; i < 3; ++i) *(LAS v4u*)(lds + (buf) * MLA_BUF + krow[i] * 400 + kch[i] * 16) = kreg[i]; \
    _Pragma("unroll") for (int i = 0; i < 2; ++i) *(LAS v4u*)(lds + (buf) * MLA_BUF + MLA_KB + vrow[i] * 320 + vch[i] * 16) = vreg[i]; } while (0)
    MLA_LOAD(0); MLA_STORE(0); __syncthreads();
    float m_ref = 0.f, l = 0.f; f32x16 o[4];
#pragma unroll
    for (int d = 0; d < 4; ++d)
#pragma unroll
        for (int r = 0; r < 16; ++r) o[d][r] = 0.f;
    const int trofs = (4 * hi + ((lane & 15) >> 2)) * 320 + (((lane >> 4) & 1) * 16 + (lane & 3) * 4) * 2;
    for (int t = 0; t < NT; ++t) {
        if (t + 1 < NT) MLA_LOAD(t + 1);
        if (t < ntw) {
            const LAS unsigned char* kb_ = lds + (t & 1) * MLA_BUF; const LAS unsigned char* vb_ = kb_ + MLA_KB;
            f32x16 p0, p1;
#pragma unroll
            for (int r = 0; r < 16; ++r) { p0[r] = 0.f; p1[r] = 0.f; }
#pragma unroll
            for (int kk = 0; kk < 12; ++kk) { const bf16x8 a0 = *(const LAS bf16x8*)(kb_ + r32 * 400 + (16 * kk + 8 * hi) * 2), a1 = *(const LAS bf16x8*)(kb_ + (32 + r32) * 400 + (16 * kk + 8 * hi) * 2);
                p0 = MFMA32(a0, qf[kk], p0); p1 = MFMA32(a1, qf[kk], p1); if ((kk % 3) == 2) __builtin_amdgcn_sched_barrier(0); }
            float rm = fmaxf(p0[0], p1[0]);
#pragma unroll
            for (int r = 1; r < 16; ++r) rm = fmaxf(rm, fmaxf(p0[r], p1[r]));
            rm = pg8::xmax32(rm);
            if (t == 0) m_ref = rm;
            else if (__any(rm > m_ref + 8.0f)) { const float mn = fmaxf(m_ref, rm), al = __builtin_amdgcn_exp2f(m_ref - mn); l *= al;
#pragma unroll
                for (int d = 0; d < 4; ++d)
#pragma unroll
                    for (int r = 0; r < 16; ++r) o[d][r] *= al;
                m_ref = mn; }
            float sum = 0.f;
#pragma unroll
            for (int r = 0; r < 16; ++r) { p0[r] = __builtin_amdgcn_exp2f(p0[r] - m_ref); p1[r] = __builtin_amdgcn_exp2f(p1[r] - m_ref); sum += p0[r] + p1[r]; }
            l += sum;
            bf16x8 pw[4];
#pragma unroll
            for (int s = 0; s < 2; ++s) { v4u w; w.x = pk2(p0[8 * s], p0[8 * s + 1]); w.y = pk2(p0[8 * s + 2], p0[8 * s + 3]); w.z = pk2(p0[8 * s + 4], p0[8 * s + 5]); w.w = pk2(p0[8 * s + 6], p0[8 * s + 7]); pw[s] = __builtin_bit_cast(bf16x8, w);
                v4u x; x.x = pk2(p1[8 * s], p1[8 * s + 1]); x.y = pk2(p1[8 * s + 2], p1[8 * s + 3]); x.z = pk2(p1[8 * s + 4], p1[8 * s + 5]); x.w = pk2(p1[8 * s + 6], p1[8 * s + 7]); pw[2 + s] = __builtin_bit_cast(bf16x8, x); }
#pragma unroll
            for (int db = 0; db < 4; ++db)
#pragma unroll
                for (int s = 0; s < 4; ++s) { const s16x4 lo = vtr(vb_ + trofs + (16 * s) * 320 + db * 64), hh = vtr(vb_ + trofs + (16 * s + 8) * 320 + db * 64);
                    const bf16x8 A = (bf16x8){lo[0], lo[1], lo[2], lo[3], hh[0], hh[1], hh[2], hh[3]};
                    o[db] = MFMA32(A, pw[s], o[db]); if (s == 3) __builtin_amdgcn_sched_barrier(0); }
        }
        if (t + 1 < NT) MLA_STORE((t + 1) & 1);
        __syncthreads();
    }
#undef MLA_LOAD
#undef MLA_STORE
    const float lt = pg8::xsum32(l), inv = 1.0f / lt;
    bf16* Op = O + (rowbase + q0 + r32) * 1024 + h * 128 + 4 * hi;
#pragma unroll
    for (int db = 0; db < 4; ++db)
#pragma unroll
        for (int g = 0; g < 4; ++g) { v2u w; w.x = pk2(o[db][4 * g] * inv, o[db][4 * g + 1] * inv); w.y = pk2(o[db][4 * g + 2] * inv, o[db][4 * g + 3] * inv); *(v2u*)(Op + 32 * db + 8 * g) = w; }
}

#ifndef UPQ_ALIGN
#define UPQ_ALIGN true
#endif
#ifndef GATE_ALIGN
#define GATE_ALIGN true
#endif
#ifndef RES_ALIGN
#define RES_ALIGN false
#endif
#ifndef INPROJ_ALIGN
#define INPROJ_ALIGN false
#endif
#ifndef PHON0
#define PHON0 1
#endif
#ifndef PHON1
#define PHON1 1
#endif
#ifndef PHON2
#define PHON2 1
#endif
#ifndef PHON3
#define PHON3 1
#endif
#ifndef PHON4
#define PHON4 1
#endif
#ifndef PHON5
#define PHON5 1
#endif
#ifndef PHON6
#define PHON6 1
#endif
#ifndef PHON7
#define PHON7 1
#endif
#ifndef PHON8
#define PHON8 1
#endif
#ifndef PHON9
#define PHON9 1
#endif
#ifndef PHON13
#define PHON13 1
#endif
#define XB_TMO      128
#define XB_XCNT(j)  (256  + 64 * (j))
#define XB_XSUB(j)  (1280 + 64 * (j))
#define XB_XGEN(j)  (2304 + 64 * (j))
#define XB_TOP      3328
#define XB_TOPGEN   3392
#define XCD_BAR_WORDS 3456
#define XB_SPIN_CAP (1u << 18)

__device__ __forceinline__ unsigned xb_ld(unsigned* p)              { return __hip_atomic_load(p, __ATOMIC_RELAXED, __HIP_MEMORY_SCOPE_AGENT); }
__device__ __forceinline__ unsigned xb_add(unsigned* p, unsigned v) { return __hip_atomic_fetch_add(p, v, __ATOMIC_RELAXED, __HIP_MEMORY_SCOPE_AGENT); }
__device__ __forceinline__ unsigned xb_xcc_id() { return (unsigned)__builtin_amdgcn_s_getreg((3 << 11) | 20) & 0xFu; }
#define XB_SPIN(cond, bar) do { unsigned _sp = 0; while (cond) { __builtin_amdgcn_s_sleep(1); \
    if ((++_sp & 255u) == 0u) { if (xb_ld(&(bar)[XB_TMO])) break; if (_sp > XB_SPIN_CAP) { atomicAdd(&(bar)[XB_TMO], 1u); break; } } } } while (0)

struct XcdBarrier {
    unsigned* bar; unsigned x;
    volatile LAS unsigned* st;
};

__device__ __forceinline__ XcdBarrier xcd_barrier_post(unsigned* bar, volatile LAS unsigned* st, bool t0) {
    XcdBarrier b; b.bar = bar; b.x = xb_xcc_id(); b.st = st;
    if (t0) (void)xb_add(&bar[XB_XCNT(b.x)], 1u);
    return b;
}
__device__ __forceinline__ void xcd_barrier_complete(unsigned* bar, unsigned x, unsigned& nloc, unsigned& nx) {
    const unsigned G = gridDim.x * gridDim.y * gridDim.z;
    unsigned sum, cnt, mine, sp = 0u;
    for (;;) {
        sum = 0u; cnt = 0u; mine = 0u;
#pragma unroll
        for (unsigned j = 0; j < 16; ++j) { const unsigned c = xb_ld(&bar[XB_XCNT(j)]); sum += c; cnt += (c > 0u) ? 1u : 0u; mine = (j == x) ? c : mine; }
        if (sum == G) break;
        __builtin_amdgcn_s_sleep(1);
        if ((++sp & 255u) == 0u) { if (xb_ld(&bar[XB_TMO])) break; if (sp > XB_SPIN_CAP) { atomicAdd(&bar[XB_TMO], 1u); break; } }
    }
    nloc = mine > 0u ? mine : 1u; nx = cnt > 0u ? cnt : 1u;
}

__device__ __forceinline__ void xcd_barrier(const XcdBarrier& b, bool t0) {
    asm volatile("s_waitcnt vmcnt(0)" ::: "memory");
    __syncthreads();
    if (t0) {
        unsigned* bar = b.bar;
        __builtin_amdgcn_s_waitcnt(0);
        unsigned nloc = b.st[0], nx = b.st[1];
        if (nloc == 0u) { xcd_barrier_complete(bar, b.x, nloc, nx); b.st[0] = nloc; b.st[1] = nx; }
        const unsigned old = xb_add(&bar[XB_XSUB(b.x)], 1u);
        const unsigned gen = old / nloc;
        if (old + 1u == (gen + 1u) * nloc) {
            __builtin_amdgcn_fence(__ATOMIC_RELEASE, "agent");
            asm volatile("s_waitcnt vmcnt(0)" ::: "memory");
            const unsigned og = xb_add(&bar[XB_TOP], 1u);
            const unsigned tg = og / nx;
            if (og + 1u == (tg + 1u) * nx) xb_add(&bar[XB_TOPGEN], 1u);
            else XB_SPIN(xb_ld(&bar[XB_TOPGEN]) == tg, bar);
            __builtin_amdgcn_fence(__ATOMIC_ACQUIRE, "agent");
            xb_add(&bar[XB_XGEN(b.x)], 1u);
            asm volatile("s_waitcnt vmcnt(0)" ::: "memory");
        } else {
            XB_SPIN(xb_ld(&bar[XB_XGEN(b.x)]) == gen, bar);
            __builtin_amdgcn_fence(__ATOMIC_ACQUIRE, "agent");
            asm volatile("s_waitcnt vmcnt(0)" ::: "memory");
        }
    }
    __syncthreads();
}

constexpr int PH_PER_LAYER = 13, N_PHASES = 2 * PH_PER_LAYER + 1;
#define WSP(T, off) ((T*)(ws + (off)))
#define WSW(off) ((bf16*)(ws + (off) + (size_t)L * W_STRIDE))
typedef const __attribute__((address_space(4))) Args* CArgs;
__device__ __forceinline__ CArgs opq_(CArgs a) { asm volatile("" : "+s"(a)); return a; }
#define APIN(i) (opq_(ap)->in[i])
#define GET_TID() int tid; asm volatile("v_mbcnt_lo_u32_b32 %0, -1, 0\n\tv_mbcnt_hi_u32_b32 %0, -1, %0" : "=v"(tid)); const int lane = tid; tid += wave_s * 64;
constexpr int I_IN = 32 * 133, I_UQ = 12 * 24, I_UKV = 8 * 32, I_SB = 16 * 32, I_OUT = 32 * 32, I_UP = 32 * 176, I_DN = 88 * 32;
constexpr int NITEMS = I_IN + I_UQ + I_UKV + 2 * I_SB + I_OUT + I_UP + I_DN;
__device__ __forceinline__ void convert_items(CArgs ap, unsigned char* ws, const int L, const int first, const int stride, const int it1, LAS float* scr, const int lane) {
    const float* w_in = APIN(2) + (size_t)L * DM * NINSRC; const float* w_uq = APIN(5) + (size_t)L * 768 * 1536; const float* w_ukv = APIN(7) + (size_t)L * 512 * 2048;
    const float* w_sb = APIN(8) + (size_t)L * 1024 * DM; const float* w_mla = APIN(9) + (size_t)L * 1024 * DM; const float* w_out = APIN(10) + (size_t)L * DM * DM;
    const float* w_up = APIN(12) + (size_t)L * DM * 2 * DFF; const float* w_dn = APIN(15) + (size_t)L * DFF * DM;
    const float* qg = APIN(4) + L * 768; const float* kvg = APIN(6) + L * 512; const float* n2g = APIN(11) + L * DM;
#pragma unroll 1
    for (int it = first; it < it1; it += stride) {
        int r = it; const float* W; int K, N, mode = 0; bf16* WT; const float* ksc = nullptr;
        if (r < I_UP) { W = w_up; K = DM; N = 2 * DFF; WT = WSW(WS_WUP); mode = 3; ksc = n2g; }
        else if ((r -= I_UP) < I_IN) { W = w_in; K = DM; N = NINSRC; WT = WSW(WS_WIN); mode = 1; }
        else if ((r -= I_IN) < I_DN) { W = w_dn; K = DFF; N = DM; WT = WSW(WS_WDN); }
        else if ((r -= I_DN) < I_OUT) { W = w_out; K = DM; N = DM; WT = WSW(WS_WOUT); }
        else if ((r -= I_OUT) < I_SB) { W = w_sb; K = 1024; N = DM; WT = WSW(WS_WSB); }
        else if ((r -= I_SB) < I_SB) { W = w_mla; K = 1024; N = DM; WT = WSW(WS_WMLA); }
        else if ((r -= I_SB) < I_UQ) { W = w_uq; K = 768; N = 1536; WT = WSW(WS_WUQ); mode = 2; ksc = qg; }
        else { r -= I_UQ; W = w_ukv; K = 512; N = 2048; WT = WSW(WS_WUKV); ksc = kvg; }
        conv_item(W, K, N, WT, mode, ksc, scr, r, lane);
    }
}
constexpr int CV_A1 = 5120, CV_A2 = 10240;
__global__ void __launch_bounds__(NTHR, 2) hybrid_fwd(Args args_) {
    extern __shared__ __attribute__((aligned(16))) unsigned char lds_raw[];
    LAS unsigned char* lds = (LAS unsigned char*)lds_raw;
    cg::grid_group grid = cg::this_grid();
    const int lo = args_.ph_lo, hi_ph = args_.ph_hi;
    const int wave_s = __builtin_amdgcn_readfirstlane(threadIdx.x >> 6);
    volatile LAS unsigned* bar_st = (volatile LAS unsigned*)(lds + LDS_BYTES - 64);
    if (threadIdx.x < 16) bar_st[threadIdx.x] = 0u;
    __syncthreads();
    const bool t0_ = (threadIdx.x == 0);
    XcdBarrier xbar = xcd_barrier_post((unsigned*)(args_.ws + WS_BAR), bar_st, t0_);
    if (hi_ph - lo > 1) grid.sync();
#pragma unroll 1
    for (int ph = lo; ph < hi_ph; ++ph) {
        CArgs ap = (CArgs)__builtin_amdgcn_kernarg_segment_ptr(); asm volatile("" : "+s"(ap));
        int G_o = gridDim.x, bx_o = blockIdx.x; asm volatile("" : "+s"(G_o), "+s"(bx_o));
        const int wave = wave_s;
        const int G = G_o, bx = bx_o;
#ifdef DBG_DELAY
        for (int dl = 0; dl < DBG_DELAY; ++dl) __builtin_amdgcn_s_sleep(127);
#endif
        const int L = ph >= PH_PER_LAYER ? 1 : 0, k = ph - L * PH_PER_LAYER;
#ifdef REP_PHASE
        const int nrep_ = (k == REP_PHASE) ? 2 : 1;
#else
        const int nrep_ = 1;
#endif
#pragma unroll 1
        for (int rep_ = 0; rep_ < nrep_; ++rep_) {
        if (PHON0 && k == 0) {
            unsigned char* ws = opq_(ap)->ws; float* X2 = opq_(ap)->out;
            GET_TID();
            const int gw = bx * NWAVES + wave, NGW = G * NWAVES, gtid = bx * NTHR + tid, NTH = G * NTHR;
            LAS float* scr = (LAS float*)(lds + wave * 16640);
            if (L == 0 || G != 256) convert_items(ap, ws, L, gw, NGW, NITEMS, scr, lane);
            else convert_items(ap, ws, 1, CV_A1 + gw, NGW, NITEMS, scr, lane);
            { bf16* Winp = WSW(WS_WIN) + (size_t)NINSRC * DM;
              for (int i = gtid; i < 192 * DM / 8; i += NTH) { unsigned z_ = 0u; asm volatile("" : "+v"(z_)); ((v4u*)Winp)[i] = (v4u){z_, z_, z_, z_}; } }
            if (L == 0) {
                f32x2* ROPE = WSP(f32x2, WS_ROPE);
                for (int i = gtid; i < SEQ_ * 32; i += NTH) { const int t = i >> 5, f = i & 31;
                    double a = 1.0;
#pragma unroll 1
                    for (int q = 0; q < f; ++q) a *= 0.7498942093324559;
                    const double a2 = a * a; double c = 1.0, s = a, tc = 1.0, ts = a;
#pragma unroll 1
                    for (int q = 1; q <= 10; ++q) { const double d1 = (double)((2 * q - 1) * (2 * q)), d2 = (double)((2 * q) * (2 * q + 1)); tc = -tc * a2 / d1; ts = -ts * a2 / d2; c += tc; s += ts; }
                    double rc = 1.0, rs = 0.0;
#pragma unroll 1
                    for (int bit = 0; bit < 12; ++bit) { if ((t >> bit) & 1) { const double nc = rc * c - rs * s, ns = rc * s + rs * c; rc = nc; rs = ns; } const double c2 = c * c - s * s, s2 = 2.0 * c * s; c = c2; s = s2; }
                    ROPE[i] = (f32x2){(float)rc, (float)rs}; }
            }
            norm_rows(L == 0 ? APIN(0) : (const float*)X2, APIN(1) + L * DM, WSP(bf16, WS_HA), nullptr, gw, NGW, lane);
        } else if (PHON1 && k == 1) {
            unsigned char* ws = opq_(ap)->ws;
            float* SSQ = WSP(float, WS_SSQP);
            pg8::Gemm g{WSP(bf16, WS_HA), WSW(WS_WIN), T_, NIN, DM}; pg8::StaticOrder S; S.init(T_, NIN, G, bx);
            pg8::EpiInProj E{ws, SSQ, SSQ + 12 * T_, APIN(3) + L * 2 * DM};
            pg8::gemm_phase<pg8::EpiInProj, pg8::StaticOrder, INPROJ_ALIGN, true>(lds, g, S, E, wave_s);
            if (L == 0 && bx >= 128 && G == 256) { GET_TID(); (void)tid; convert_items(ap, ws, 1, (bx - 128) * NWAVES + wave, 128 * NWAVES, CV_A1, (LAS float*)(lds + wave * 16640), lane); __syncthreads(); }
        } else if (PHON2 && k == 2) {
            unsigned char* ws = opq_(ap)->ws;
            float* SSQ = WSP(float, WS_SSQP);
            { pg8::Gemm g{WSP(bf16, WS_CQ), WSW(WS_WUQ), T_, 1536, 768}; pg8::StaticOrder S; S.init(T_, 1536, G, bx); pg8::EpiQUp E{WSP(bf16, WS_QM), SSQ, WSP(f32x2, WS_ROPE)};
              pg8::gemm_phase<pg8::EpiQUp, pg8::StaticOrder, UPQ_ALIGN, true>(lds, g, S, E, wave_s); }
            { pg8::Gemm g{WSP(bf16, WS_CKV), WSW(WS_WUKV), T_, 2048, 512}; pg8::StaticOrder S; S.init(T_, 2048, G, bx); pg8::EpiKvUp E{WSP(bf16, WS_KV), SSQ + 12 * T_};
              pg8::gemm_phase<pg8::EpiKvUp, pg8::StaticOrder, UPQ_ALIGN, true>(lds, g, S, E, wave_s); }
#pragma unroll 1
            for (int p = bx; p < 256; p += G) { const int bh = p >> 3, s = p & 7;
#ifdef REP_SB
#pragma unroll 1
                for (int j = 0; j < 2; ++j) sb_unit(WSP(bf16, WS_SBQ), WSP(bf16, WS_SBK), WSP(bf16, WS_SBV), WSP(bf16, WS_SBQ), bh >> 3, bh & 7, j ? 15 - s : s, lds, wave_s, false);
#endif
#ifndef SKIP_SBATT
#pragma unroll 1
                for (int j = 0; j < 2; ++j) sb_unit(WSP(bf16, WS_SBQ), WSP(bf16, WS_SBK), WSP(bf16, WS_SBV), WSP(bf16, WS_SBQ), bh >> 3, bh & 7, j ? 15 - s : s, lds, wave_s);
#endif
            }
            __syncthreads();
        } else if (PHON3 && k == 3) {
            unsigned char* ws = opq_(ap)->ws;
#pragma unroll 1
            for (int p = bx; p < 256; p += G) { const int bh = p >> 3, s = p & 7;
#pragma unroll 1
                for (int j = 0; j < 2; ++j) mla_unit(WSP(bf16, WS_QM), WSP(bf16, WS_KV), WSP(bf16, WS_KR), WSP(bf16, WS_OMLA), bh >> 3, bh & 7, j ? 15 - s : s, lds, wave_s); }
        } else if (PHON4 && k == 4) {
            unsigned char* ws = opq_(ap)->ws;
            { pg8::Gemm g{WSP(bf16, WS_SBQ), WSW(WS_WSB), T_, DM, 1024}; pg8::StaticOrder S; S.init(T_, DM, G, bx); pg8::EpiGate<true> E{WSP(bf16, WS_GSB), WSP(float, WS_X1), nullptr};
              pg8::gemm_phase<pg8::EpiGate<true>, pg8::StaticOrder, GATE_ALIGN, true>(lds, g, S, E, wave_s); }
            { pg8::Gemm g{WSP(bf16, WS_OMLA), WSW(WS_WMLA), T_, DM, 1024}; pg8::StaticOrder S; S.init(T_, DM, G, bx); pg8::EpiGate<false> E{WSP(bf16, WS_GMLA), WSP(float, WS_X1), WSP(bf16, WS_MIX)};
              pg8::gemm_phase<pg8::EpiGate<false>, pg8::StaticOrder, GATE_ALIGN, true>(lds, g, S, E, wave_s); }
        } else if (PHON5 && k == 5) {
            unsigned char* ws = opq_(ap)->ws; float* X2 = opq_(ap)->out;
            pg8::Gemm g{WSP(bf16, WS_MIX), WSW(WS_WOUT), T_, DM, DM}; pg8::StaticOrder S; S.init(T_, DM, G, bx); pg8::EpiResidStat E{L == 0 ? APIN(0) : (const float*)X2, WSP(float, WS_X1), WSP(bf16, WS_HA), WSP(float, WS_SSQP)};
            pg8::gemm_phase<pg8::EpiResidStat, pg8::StaticOrder, RES_ALIGN, true>(lds, g, S, E, wave_s);
        } else if (PHON6 && k == 6) {
            unsigned char* ws = opq_(ap)->ws;
            GET_TID(); (void)lane;
            { const float* slots = WSP(float, WS_SSQP); float* rstd = WSP(float, WS_SSQ);
              for (int row = bx * NTHR + tid; row < T_; row += G * NTHR) { const f32x4* sp = (const f32x4*)(slots + (size_t)row * 32); f32x4 t = sp[0];
#pragma unroll
                  for (int j = 1; j < 8; ++j) t += sp[j];
                  rstd[row] = 1.0f / sqrtf(((t[0] + t[1]) + (t[2] + t[3])) * (1.0f / 2048.0f) + 1e-6f); } }
        } else if (PHON13 && k == 13) {
            unsigned char* ws = opq_(ap)->ws; float* X2 = opq_(ap)->out; (void)ws;
            GET_TID();
#ifdef DBG_DUMP
            {
                const bf16* src = (const bf16*)(ws + DBG_DUMP);
                for (size_t i = (size_t)(bx * NTHR + tid); i < (size_t)T_ * DM; i += (size_t)G * NTHR) X2[i] = pg8::bf_lo((unsigned)src[i]);
            }
            if (false) norm_rows(X2, APIN(16), nullptr, X2,
#elif defined(DBG_STOP) && !defined(DBG_FINAL_X2)
            norm_rows(WSP(float, WS_X1), APIN(16), nullptr, X2,
#else
            norm_rows(X2, APIN(16), nullptr, X2,
#endif
 bx * NWAVES + wave, G * NWAVES, lane);
        } else {
            unsigned char* ws = opq_(ap)->ws; float* X2 = opq_(ap)->out;
            if (PHON7 && k == 7) {
                pg8::Gemm g{WSP(bf16, WS_HA), WSW(WS_WUP), T_, 2 * DFF, DM}; pg8::StaticOrder S; S.init(T_, 2 * DFF, G, bx);
                pg8::EpiUpConv E{WSP(bf16, WS_ACT), WSP(float, WS_SSQ), APIN(13) + (size_t)L * 3 * 2 * DFF, APIN(14) + (size_t)L * 2 * DFF, WSP(float, WS_YL), WSP(float, WS_YF), (LAS float*)(lds + 131072)};
                pg8::gemm_phase<pg8::EpiUpConv, pg8::StaticOrder, true, true>(lds, g, S, E, wave_s);
            } else if (PHON8 && k == 8) {
                GET_TID(); (void)lane;
                const float* cw = APIN(13) + (size_t)L * 3 * 2 * DFF; const float* cb = APIN(14) + (size_t)L * 2 * DFF;
                const float* yl = WSP(float, WS_YL); const float* yf = WSP(float, WS_YF); bf16* act = WSP(bf16, WS_ACT);
                for (int idx = bx * NTHR + tid; idx < 64 * DFF; idx += G * NTHR) { const int pm = idx / DFF, ch = idx - pm * DFF;
                    if ((pm & 15) == 0) continue;
                    float c2[2][2];
#pragma unroll
                    for (int bj = 0; bj < 2; ++bj) { const int c = bj * DFF + ch; const float w0 = cw[c], w1 = cw[2 * DFF + c], w2 = cw[4 * DFF + c], b0 = cb[c];
                        const float l0 = yl[((size_t)((pm - 1) * 2 + 0) * 2 + bj) * DFF + ch], l1 = yl[((size_t)((pm - 1) * 2 + 1) * 2 + bj) * DFF + ch];
                        const float f0 = yf[((size_t)(pm * 2 + 0) * 2 + bj) * DFF + ch], f1 = yf[((size_t)(pm * 2 + 1) * 2 + bj) * DFF + ch];
                        c2[bj][0] = b0 + w0 * l0 + w1 * l1 + w2 * f0; c2[bj][1] = b0 + w0 * l1 + w1 * f0 + w2 * f1; }
#pragma unroll
                    for (int r = 0; r < 2; ++r) { const float Gv = c2[0][r]; act[(size_t)(pm * 256 + r) * DFF + ch] = (bf16)(pg8::cvt_pk_bf16(Gv * pg8::sigmoidf_(Gv) * c2[1][r], 0.f) & 0xffffu); }
                }
            } else if (PHON9 && k == 9) {
                pg8::Gemm g{WSP(bf16, WS_ACT), WSW(WS_WDN), T_, DM, DFF}; pg8::StaticOrder S; S.init(T_, DM, G, bx); pg8::EpiResid E{WSP(float, WS_X1), X2};
                pg8::gemm_phase<pg8::EpiResid, pg8::StaticOrder, RES_ALIGN, true>(lds, g, S, E, wave_s);
            }
        }
        }
        if (ph + 1 < hi_ph && !(k >= 10 && k <= 12)) { int l0_; asm volatile("v_mbcnt_lo_u32_b32 %0, -1, 0\n\tv_mbcnt_hi_u32_b32 %0, -1, %0" : "=v"(l0_)); xcd_barrier(xbar, wave_s == 0 && l0_ == 0);
#ifdef REP_BAR
            xcd_barrier(xbar, wave_s == 0 && l0_ == 0); xcd_barrier(xbar, wave_s == 0 && l0_ == 0);
#endif
        }
    }
}

#ifndef MK_PER_PHASE
#define MK_PER_PHASE 0
#endif
extern "C" void kernel_launch(void* const* d_in, const int* in_sizes, int n_in, void* d_out, int out_size, void* d_ws, size_t ws_size, hipStream_t stream) {
    static int grid = 0;
    if (grid == 0) {
        if (n_in != 17 || out_size != T_ * DM || ws_size < WS_END) { fprintf(stderr, "kernel_launch: unexpected shapes (n_in %d, out %d, ws %zu)\n", n_in, out_size, ws_size); grid = -1; return; }
        int dev = 0, cus = 0, per_cu = 0;
        hipGetDevice(&dev); hipDeviceGetAttribute(&cus, hipDeviceAttributeMultiprocessorCount, dev);
        hipFuncSetAttribute((const void*)hybrid_fwd, hipFuncAttributeMaxDynamicSharedMemorySize, LDS_BYTES);
        hipOccupancyMaxActiveBlocksPerMultiprocessor(&per_cu, (const void*)hybrid_fwd, NTHR, LDS_BYTES);
        (void)hipGetLastError();
        if (per_cu < 1) per_cu = 1;
        grid = cus * 1;
    }
    if (grid < 0) return;
#ifdef DBG_CLEAR_LO
    (void)hipMemsetAsync((char*)d_ws + (size_t)DBG_CLEAR_LO * MiB, 0, (size_t)(DBG_CLEAR_HI - DBG_CLEAR_LO) * MiB, stream);
#endif
    if (hipMemsetAsync((char*)d_ws + WS_BAR, 0, 16384, stream) != hipSuccess) { fprintf(stderr, "kernel_launch: memset of the barrier words failed\n"); return; }
    Args a{};
    for (int i = 0; i < 17; ++i) a.in[i] = (const float*)d_in[i];
    a.out = (float*)d_out; a.ws = (unsigned char*)d_ws;
#if MK_PER_PHASE
    for (int p = 0; p < N_PHASES; ++p) {
#ifdef DBG_STOP
        if (p >= DBG_STOP && p != N_PHASES - 1) continue;
#endif
        a.ph_lo = p; a.ph_hi = p + 1; void* kargs[] = {&a};
        hipError_t e = hipLaunchCooperativeKernel((const void*)hybrid_fwd, dim3(grid), dim3(NTHR), kargs, LDS_BYTES, stream);
        if (e != hipSuccess) { fprintf(stderr, "launch %d failed: %s\n", p, hipGetErrorString(e)); break; } }
#else
    a.ph_lo = 0; a.ph_hi = N_PHASES; void* kargs[] = {&a};
    hipError_t e = hipLaunchCooperativeKernel((const void*)hybrid_fwd, dim3(grid), dim3(NTHR), kargs, LDS_BYTES, stream);
    if (e != hipSuccess) fprintf(stderr, "cooperative launch failed: %s (grid %d)\n", hipGetErrorString(e), grid);
#endif
}
```

```cpp
#include <hip/hip_runtime.h>
#include <hip/hip_cooperative_groups.h>
#include <cstdio>
#include <cstdint>
#include <cmath>
namespace cg = cooperative_groups;
constexpr int NWAVES = 8, NTHR = 512;
constexpr int T_ = 16384, SEQ_ = 4096, DM = 2048, DFF = 5632, NIN = 8704, NINSRC = 8512;
constexpr size_t MiB = 1u << 20;
constexpr size_t WS_SSQ = 0;
constexpr size_t WS_ROPE = 1 * MiB;
constexpr size_t WS_WIN = 2 * MiB, WS_WUQ = 36 * MiB, WS_WUKV = WS_WUQ + 2304 * 1024, WS_WSB = WS_WUKV + 2 * MiB, WS_WMLA = WS_WSB + 4 * MiB, WS_WOUT = WS_WMLA + 4 * MiB,
                 WS_WUP = WS_WOUT + 8 * MiB, WS_WDN = WS_WUP + 44 * MiB;
constexpr size_t W_STRIDE = 121 * MiB;
constexpr size_t WS_BAR = 512 * 1024;
constexpr size_t WS_X1 = 244 * MiB;
constexpr size_t WS_R = 372 * MiB;
constexpr size_t WS_HA = WS_R, WS_KV = WS_R;
constexpr size_t WS_SBQ = WS_R + 64 * MiB, WS_SBK = WS_R + 96 * MiB, WS_SBV = WS_R + 128 * MiB, WS_MIX = WS_SBK;
constexpr size_t WS_CQ = WS_R + 160 * MiB, WS_CKV = WS_R + 184 * MiB, WS_OMLA = WS_CQ;
constexpr size_t WS_KR = WS_R + 200 * MiB, WS_GSB = WS_R + 202 * MiB, WS_GMLA = WS_R + 266 * MiB, WS_QM = WS_X1;
constexpr size_t WS_ACT = WS_R + 64 * MiB, WS_YL = WS_R + 240 * MiB, WS_YF = WS_R + 246 * MiB;
constexpr size_t WS_SSQP = WS_R + 330 * MiB;
constexpr size_t WS_END = WS_R + 332 * MiB;

namespace pg8 {
#define PG8_LAS __attribute__((address_space(3)))
typedef unsigned short bf16_t;
typedef short bf16x8 __attribute__((ext_vector_type(8)));
typedef float f32x4 __attribute__((ext_vector_type(4)));
typedef unsigned u32x4 __attribute__((ext_vector_type(4)));
constexpr int BM = 256, BK = 64, HALF = 128, HTB = HALF * BK * 2  , STAGE_BYTES = 8 * HTB, NXCD = 8, WGM = 8;

__host__ __device__ __forceinline__ int lds_byte(int r, int c) { const int st = (r >> 4) * 2 + (c >> 5), rr = r & 15, cc = c & 31, ob = rr * 64 + cc * 2; return st * 1024 + (ob ^ (((ob >> 9) & 1) << 5)); }
__host__ __device__ __forceinline__ void stage_rc(int b, int& R, int& C) { const int st = b / 1024, sb = b % 1024, swz = sb ^ (((sb >> 9) & 1) << 5); R = (st >> 1) * 16 + swz / 64; C = (st & 1) * 32 + (swz % 64) / 2; }
__host__ __device__ __forceinline__ int perm32(int rho) { const int n = rho >> 4, i = rho & 15; return 8 * (i >> 2) + 4 * n + (i & 3); }

struct Unit { int pm, pn; };
struct Gemm { const bf16_t* A; const bf16_t* Bt; int M, N, K; };

struct StaticOrder {
    int nM, nN, nwg, G, c;
    __host__ __device__ void init(int M, int N, int G_, int c_) { nM = M / BM; nN = N / BM; nwg = nM * nN; G = G_; c = c_; }
    __host__ __device__ bool next(int i, Unit& u) const {
        const long L = (long)i * G + c; if (L >= nwg) return false;
        int wgid = (int)L; { const int q = nwg / NXCD, r = nwg % NXCD, xcd = wgid % NXCD, off = wgid / NXCD; wgid = (xcd < r ? xcd * (q + 1) : r * (q + 1) + (xcd - r) * q) + off; }
        const int nig = WGM * nN, gid = wgid / nig, fm = gid * WGM, gsz = (nM - fm) < WGM ? (nM - fm) : WGM;
        u.pm = fm + ((wgid % nig) % gsz); u.pn = (wgid % nig) / gsz; return true;
    }
    __device__ __forceinline__ void a_ready(const Unit&) const {}
    __device__ __forceinline__ void done(const Unit&) const {}
};
typedef float f32x2_cv __attribute__((ext_vector_type(2))); typedef __bf16 bf16x2_cv __attribute__((ext_vector_type(2)));
__device__ __forceinline__ unsigned cvt_pk_bf16(float lo, float hi) { const f32x2_cv v = {lo, hi}; const bf16x2_cv b = __builtin_convertvector(v, bf16x2_cv); return __builtin_bit_cast(unsigned, b); }
typedef float f32x2 __attribute__((ext_vector_type(2)));
typedef unsigned u32x2_ __attribute__((ext_vector_type(2)));
__device__ __forceinline__ float xsum32(float v) { const u32x2_ r = __builtin_amdgcn_permlane32_swap(__float_as_uint(v), __float_as_uint(v), false, false); return __uint_as_float(r[0]) + __uint_as_float(r[1]); }
__device__ __forceinline__ float xsum16(float v) { const u32x2_ r = __builtin_amdgcn_permlane16_swap(__float_as_uint(v), __float_as_uint(v), false, false); return __uint_as_float(r[0]) + __uint_as_float(r[1]); }
__device__ __forceinline__ float xmax32(float v) { const u32x2_ r = __builtin_amdgcn_permlane32_swap(__float_as_uint(v), __float_as_uint(v), false, false); return fmaxf(__uint_as_float(r[0]), __uint_as_float(r[1])); }
__device__ __forceinline__ float xother32(float v, int hi) { const u32x2_ r = __builtin_amdgcn_permlane32_swap(__float_as_uint(v), __float_as_uint(v), false, false); return __uint_as_float(hi ? r[0] : r[1]); }
template <int CTRL> __device__ __forceinline__ float dpp_(float v) { return __uint_as_float(__builtin_amdgcn_update_dpp(0u, __float_as_uint(v), CTRL, 0xf, 0xf, false)); }
__device__ __forceinline__ float wave_sum_(float v) { v += dpp_<0xB1>(v); v += dpp_<0x4E>(v); v += dpp_<0x141>(v); v += dpp_<0x140>(v); v = xsum16(v); return xsum32(v); }
__device__ __forceinline__ u32x4 pack8(const f32x4 v0, const f32x4 v1) { u32x4 w; w.x = cvt_pk_bf16(v0[0], v0[1]); w.y = cvt_pk_bf16(v0[2], v0[3]); w.z = cvt_pk_bf16(v1[0], v1[1]); w.w = cvt_pk_bf16(v1[2], v1[3]); return w; }
__device__ __forceinline__ float bf_lo(unsigned w) { return __uint_as_float(w << 16); }
__device__ __forceinline__ float bf_hi(unsigned w) { return __uint_as_float(w & 0xffff0000u); }
__device__ __forceinline__ float sigmoidf_(float x) { return __builtin_amdgcn_rcpf(1.0f + __builtin_amdgcn_exp2f(-1.4426950408889634f * x)); }

#ifdef DBG_SWAPKV
#define DBG_SWAP(x) ((x) == 0 ? 0 : 3 - (x))
#else
#define DBG_SWAP(x) (x)
#endif
constexpr float SBQ_SCALE = 0.12751743082459868f;
constexpr float MLAQ_SCALE = 0.10411754627697264f;
constexpr float EPS_ = 1e-6f;

struct EpiInProj {
    static constexpr bool PERM = true, AFTER_DRAIN = false, APERM = false;
    unsigned char* ws; float *ssq_q, *ssq_kv; const float* bgate;
    template <int LDC, bool SSQ, int NSLOT = 1> static __device__ __forceinline__ void plain(const f32x4 (&acc)[2][2][4][2], bf16_t* dst, float* ssq, int rowb, int fq, float sc) {
#pragma unroll
        for (int ai = 0; ai < 2; ++ai)
#pragma unroll
            for (int m = 0; m < 4; ++m) { const int row = rowb + ai * HALF + m * 16; float ss = 0.f;
#pragma unroll
                for (int bj = 0; bj < 2; ++bj) { const f32x4 v0 = acc[ai][bj][m][0] * sc, v1 = acc[ai][bj][m][1] * sc;
                    if (SSQ) ss += (v0[0] * v0[0] + v0[1] * v0[1]) + (v0[2] * v0[2] + v0[3] * v0[3]) + (v1[0] * v1[0] + v1[1] * v1[1]) + (v1[2] * v1[2] + v1[3] * v1[3]);
                    *(u32x4*)(dst + (size_t)row * LDC + bj * HALF) = pack8(v0, v1); }
                if (SSQ) { ss = xsum16(ss); ss = xsum32(ss); if (fq == 0) ssq[(size_t)row * NSLOT] = ss; }
                asm volatile("" ::: "memory"); }
    }
    __device__ __forceinline__ void operator()(const f32x4 (&acc)[2][2][4][2], const Unit& u, int wr, int wc, int fr, int fq) const {
        const int pn = u.pn, rowb = u.pm * BM + wr * 64 + fr, cw = wc * 32 + fq * 8;
        if (pn < 12) { bf16_t* dst = (bf16_t*)(ws + WS_SBQ + (size_t)(DBG_SWAP(pn >> 2)) * (32u << 20)); plain<1024, false>(acc, dst + (pn & 3) * BM + cw, nullptr, rowb, fq, pn < 4 ? SBQ_SCALE : 1.0f);
        } else if (pn < 15) { plain<768, true, 12>(acc, (bf16_t*)(ws + WS_CQ) + (pn - 12) * BM + cw, ssq_q + (pn - 12) * 4 + wc, rowb, fq, 1.0f);
        } else if (pn < 17) { plain<512, true, 8>(acc, (bf16_t*)(ws + WS_CKV) + (pn - 15) * BM + cw, ssq_kv + (pn - 15) * 4 + wc, rowb, fq, 1.0f);
        } else if (pn < 33) {
            bf16_t* dst = (bf16_t*)(ws + WS_GSB + (size_t)((pn - 17) >> 3) * (64u << 20)); const int ct = (pn - 17) & 7; const float* bp = bgate + (pn - 17) * BM + cw;
            f32x4 bv[2][2];
#pragma unroll
            for (int bj = 0; bj < 2; ++bj)
#pragma unroll
#ifdef DBG_NOBIAS
                for (int n = 0; n < 2; ++n) bv[bj][n] = (f32x4){0.f, 0.f, 0.f, 0.f};
#else
                for (int n = 0; n < 2; ++n) bv[bj][n] = *(const f32x4*)(bp + bj * HALF + 4 * n);
#endif
#pragma unroll
            for (int ai = 0; ai < 2; ++ai)
#pragma unroll
                for (int m = 0; m < 4; ++m) { const int row = rowb + ai * HALF + m * 16;
#pragma unroll
                    for (int bj = 0; bj < 2; ++bj) { f32x4 v0 = acc[ai][bj][m][0] + bv[bj][0], v1 = acc[ai][bj][m][1] + bv[bj][1];
#pragma unroll
                        for (int e = 0; e < 4; ++e) { v0[e] = sigmoidf_(v0[e]); v1[e] = sigmoidf_(v1[e]); }
                        *(u32x4*)(dst + (size_t)row * 2048 + ct * BM + bj * HALF + cw) = pack8(v0, v1); }
                    asm volatile("" ::: "memory"); }
        } else {
            if (wc < 2) {
#pragma unroll
                for (int ai = 0; ai < 2; ++ai)
#pragma unroll
                    for (int m = 0; m < 4; ++m) { const int row = rowb + ai * HALF + m * 16; const f32x2* rp = (const f32x2*)(ws + WS_ROPE) + (size_t)(row & 4095) * 32 + (cw >> 1);
                        f32x4 v0 = acc[ai][0][m][0], v1 = acc[ai][0][m][1];
                        const f32x2 c0 = rp[0], c1 = rp[1], c2 = rp[2], c3 = rp[3];
                        f32x4 o0, o1;
                        o0[0] = v0[0] * c0.x - v0[1] * c0.y; o0[1] = v0[0] * c0.y + v0[1] * c0.x; o0[2] = v0[2] * c1.x - v0[3] * c1.y; o0[3] = v0[2] * c1.y + v0[3] * c1.x;
                        o1[0] = v1[0] * c2.x - v1[1] * c2.y; o1[1] = v1[0] * c2.y + v1[1] * c2.x; o1[2] = v1[2] * c3.x - v1[3] * c3.y; o1[3] = v1[2] * c3.y + v1[3] * c3.x;
                        *(u32x4*)((bf16_t*)(ws + WS_KR) + (size_t)row * 64 + cw) = pack8(o0, o1); asm volatile("" ::: "memory"); }
            }
        }
    }
};

struct EpiQUp {
    static constexpr bool PERM = true, AFTER_DRAIN = false, APERM = false;
    bf16_t* out; const float* ssq; const f32x2* rope;
    __device__ __forceinline__ void operator()(const f32x4 (&acc)[2][2][4][2], const Unit& u, int wr, int wc, int fr, int fq) const {
        const int rowb = u.pm * BM + wr * 64 + fr, cw = wc * 32 + fq * 8;
#pragma unroll
        for (int ai = 0; ai < 2; ++ai)
#pragma unroll
            for (int m = 0; m < 4; ++m) { const int row = rowb + ai * HALF + m * 16; const f32x4 s0 = *(const f32x4*)(ssq + (size_t)row * 12), s1 = *(const f32x4*)(ssq + (size_t)row * 12 + 4), s2 = *(const f32x4*)(ssq + (size_t)row * 12 + 8);
                const float sst = (((s0[0] + s0[1]) + (s0[2] + s0[3])) + ((s1[0] + s1[1]) + (s1[2] + s1[3]))) + ((s2[0] + s2[1]) + (s2[2] + s2[3]));
                const float rs = __builtin_amdgcn_rsqf(sst * (1.0f / 768.0f) + EPS_) * MLAQ_SCALE;
#pragma unroll
                for (int bj = 0; bj < 2; ++bj) { const int c = u.pn * BM + bj * HALF + cw, within = c % 192;
                    f32x4 v0 = acc[ai][bj][m][0] * rs, v1 = acc[ai][bj][m][1] * rs;
                    if (within >= 128) { const f32x2* rp = rope + (size_t)(row & 4095) * 32 + ((within - 128) >> 1);
                        const f32x2 c0 = rp[0], c1 = rp[1], c2 = rp[2], c3 = rp[3]; f32x4 o0, o1;
                        o0[0] = v0[0] * c0.x - v0[1] * c0.y; o0[1] = v0[0] * c0.y + v0[1] * c0.x; o0[2] = v0[2] * c1.x - v0[3] * c1.y; o0[3] = v0[2] * c1.y + v0[3] * c1.x;
                        o1[0] = v1[0] * c2.x - v1[1] * c2.y; o1[1] = v1[0] * c2.y + v1[1] * c2.x; o1[2] = v1[2] * c3.x - v1[3] * c3.y; o1[3] = v1[2] * c3.y + v1[3] * c3.x;
                        v0 = o0; v1 = o1; }
                    *(u32x4*)(out + (size_t)row * 1536 + c) = pack8(v0, v1); }
                asm volatile("" ::: "memory"); }
    }
};
struct EpiKvUp {
    static constexpr bool PERM = true, AFTER_DRAIN = false, APERM = false;
    bf16_t* out; const float* ssq;
    __device__ __forceinline__ void operator()(const f32x4 (&acc)[2][2][4][2], const Unit& u, int wr, int wc, int fr, int fq) const {
        const int rowb = u.pm * BM + wr * 64 + fr, cw = wc * 32 + fq * 8;
#pragma unroll
        for (int ai = 0; ai < 2; ++ai)
#pragma unroll
            for (int m = 0; m < 4; ++m) { const int row = rowb + ai * HALF + m * 16; const f32x4 s0 = *(const f32x4*)(ssq + (size_t)row * 8), s1 = *(const f32x4*)(ssq + (size_t)row * 8 + 4);
                const float sst = ((s0[0] + s0[1]) + (s0[2] + s0[3])) + ((s1[0] + s1[1]) + (s1[2] + s1[3]));
                const float rs = __builtin_amdgcn_rsqf(sst * (1.0f / 512.0f) + EPS_);
#pragma unroll
                for (int bj = 0; bj < 2; ++bj) *(u32x4*)(out + (size_t)row * 2048 + u.pn * BM + bj * HALF + cw) = pack8(acc[ai][bj][m][0] * rs, acc[ai][bj][m][1] * rs); }
    }
};
struct EpiPlain {
    static constexpr bool PERM = true, AFTER_DRAIN = false, APERM = false;
    bf16_t* out; int ldc;
    __device__ __forceinline__ void operator()(const f32x4 (&acc)[2][2][4][2], const Unit& u, int wr, int wc, int fr, int fq) const {
        const int rowb = u.pm * BM + wr * 64 + fr, cw = wc * 32 + fq * 8;
#pragma unroll
        for (int ai = 0; ai < 2; ++ai)
#pragma unroll
            for (int m = 0; m < 4; ++m) { const int row = rowb + ai * HALF + m * 16;
#pragma unroll
                for (int bj = 0; bj < 2; ++bj) *(u32x4*)(out + (size_t)row * ldc + u.pn * BM + bj * HALF + cw) = pack8(acc[ai][bj][m][0], acc[ai][bj][m][1]); }
    }
};
template <bool FIRST> struct EpiGate {
    static constexpr bool PERM = true, AFTER_DRAIN = false, APERM = false;
    const bf16_t* gate; float* part; bf16_t* out;
    __device__ __forceinline__ void operator()(const f32x4 (&acc)[2][2][4][2], const Unit& u, int wr, int wc, int fr, int fq) const {
        const int rowb = u.pm * BM + wr * 64 + fr, cw = wc * 32 + fq * 8;
#pragma unroll
        for (int ai = 0; ai < 2; ++ai)
#pragma unroll
            for (int m = 0; m < 4; ++m) { const int row = rowb + ai * HALF + m * 16;
#pragma unroll
                for (int bj = 0; bj < 2; ++bj) { const size_t off = (size_t)row * 2048 + u.pn * BM + bj * HALF + cw;
                    const u32x4 g = *(const u32x4*)(gate + off);
                    f32x4 v0 = acc[ai][bj][m][0], v1 = acc[ai][bj][m][1];
                    v0[0] *= bf_lo(g.x); v0[1] *= bf_hi(g.x); v0[2] *= bf_lo(g.y); v0[3] *= bf_hi(g.y); v1[0] *= bf_lo(g.z); v1[1] *= bf_hi(g.z); v1[2] *= bf_lo(g.w); v1[3] *= bf_hi(g.w);
#ifdef SKIP_SB
                    if (FIRST) { v0 *= 0.f; v1 *= 0.f; }
#endif
#ifdef SKIP_MLA
                    if (!FIRST) { v0 *= 0.f; v1 *= 0.f; }
#endif
                    bf16_t* pb = (bf16_t*)part;
                    if (FIRST) { *(u32x4*)(pb + off) = pack8(v0, v1); }
                    else { const u32x4 q = *(const u32x4*)(pb + off);
                        v0[0] += bf_lo(q.x); v0[1] += bf_hi(q.x); v0[2] += bf_lo(q.y); v0[3] += bf_hi(q.y); v1[0] += bf_lo(q.z); v1[1] += bf_hi(q.z); v1[2] += bf_lo(q.w); v1[3] += bf_hi(q.w);
                        *(u32x4*)(out + off) = pack8(v0, v1); } } }
    }
};
struct EpiResid {
    static constexpr bool PERM = true, AFTER_DRAIN = false, APERM = false;
    const float* base; float* out;
    __device__ __forceinline__ void operator()(const f32x4 (&acc)[2][2][4][2], const Unit& u, int wr, int wc, int fr, int fq) const {
        const int rowb = u.pm * BM + wr * 64 + fr, cw = wc * 32 + fq * 8;
#pragma unroll
        for (int ai = 0; ai < 2; ++ai)
#pragma unroll
            for (int m = 0; m < 4; ++m) { const int row = rowb + ai * HALF + m * 16;
#pragma unroll
                for (int bj = 0; bj < 2; ++bj) { const size_t off = (size_t)row * 2048 + u.pn * BM + bj * HALF + cw;
                    *(f32x4*)(out + off) = *(const f32x4*)(base + off) + acc[ai][bj][m][0]; *(f32x4*)(out + off + 4) = *(const f32x4*)(base + off + 4) + acc[ai][bj][m][1]; } }
    }
};

struct EpiResidStat {
    static constexpr bool PERM = true, AFTER_DRAIN = false, APERM = false;
    const float* base; float* out; bf16_t* hb; float* slots;
    __device__ __forceinline__ void operator()(const f32x4 (&acc)[2][2][4][2], const Unit& u, int wr, int wc, int fr, int fq) const {
        const int rowb = u.pm * BM + wr * 64 + fr, cw = wc * 32 + fq * 8;
#pragma unroll
        for (int ai = 0; ai < 2; ++ai)
#pragma unroll
            for (int m = 0; m < 4; ++m) { const int row = rowb + ai * HALF + m * 16; float ss = 0.f;
#pragma unroll
                for (int bj = 0; bj < 2; ++bj) { const size_t off = (size_t)row * 2048 + u.pn * BM + bj * HALF + cw;
                    const f32x4 v0 = *(const f32x4*)(base + off) + acc[ai][bj][m][0], v1 = *(const f32x4*)(base + off + 4) + acc[ai][bj][m][1];
                    *(f32x4*)(out + off) = v0; *(f32x4*)(out + off + 4) = v1; *(u32x4*)(hb + off) = pack8(v0, v1);
                    ss += (v0[0] * v0[0] + v0[1] * v0[1]) + (v0[2] * v0[2] + v0[3] * v0[3]) + (v1[0] * v1[0] + v1[1] * v1[1]) + (v1[2] * v1[2] + v1[3] * v1[3]); }
                ss = xsum16(ss); ss = xsum32(ss); if (fq == 0) slots[(size_t)row * 32 + u.pn * 4 + wc] = ss;
                asm volatile("" ::: "memory"); }
    }
};
struct EpiPlainScaled {
    static constexpr bool PERM = true, AFTER_DRAIN = false, APERM = false;
    bf16_t* out; int ldc; const float* rstd;
    __device__ __forceinline__ void operator()(const f32x4 (&acc)[2][2][4][2], const Unit& u, int wr, int wc, int fr, int fq) const {
        const int rowb = u.pm * BM + wr * 64 + fr, cw = wc * 32 + fq * 8;
        float rs[2][4];
#pragma unroll
        for (int ai = 0; ai < 2; ++ai)
#pragma unroll
            for (int m = 0; m < 4; ++m) rs[ai][m] = rstd[rowb + ai * HALF + m * 16];
#pragma unroll
        for (int ai = 0; ai < 2; ++ai)
#pragma unroll
            for (int m = 0; m < 4; ++m) { const int row = rowb + ai * HALF + m * 16;
#pragma unroll
                for (int bj = 0; bj < 2; ++bj) *(u32x4*)(out + (size_t)row * ldc + u.pn * BM + bj * HALF + cw) = pack8(acc[ai][bj][m][0] * rs[ai][m], acc[ai][bj][m][1] * rs[ai][m]); }
    }
};

struct EpiUpConv {
    static constexpr bool PERM = true, AFTER_DRAIN = false, APERM = true;
    bf16_t* act; const float* rstd; const float* cw; const float* cb; float* yl; float* yf; PG8_LAS float* xl;
    __device__ __forceinline__ void operator()(const f32x4 (&acc)[2][2][4][2], const Unit& u, int wr, int wc, int fr, int fq) const {
        const int row0 = u.pm * BM + wr * 128 + fr * 8, chl = wc * 32 + fq * 8, ch0 = u.pn * 128 + chl;
        float rs[8];
#pragma unroll
        for (int j = 0; j < 8; ++j) rs[j] = rstd[row0 + j];
        PG8_LAS float* xw = xl + (wc * 4 + fq) * 64;
        if (fr == 15) {
            if (wr == 0) {
#pragma unroll
                for (int bj = 0; bj < 2; ++bj)
#pragma unroll
                    for (int n = 0; n < 2; ++n)
#pragma unroll
                        for (int e = 0; e < 4; ++e) { xw[((bj * 2 + n) * 4 + e) * 2 + 0] = acc[1][bj][2][n][e] * rs[6]; xw[((bj * 2 + n) * 4 + e) * 2 + 1] = acc[1][bj][3][n][e] * rs[7]; }
            } else {
#pragma unroll
                for (int bj = 0; bj < 2; ++bj)
#pragma unroll
                    for (int n = 0; n < 2; ++n) { *(f32x4*)(yl + ((size_t)(u.pm * 2 + 0) * 2 + bj) * 5632 + ch0 + 4 * n) = acc[1][bj][2][n] * rs[6]; *(f32x4*)(yl + ((size_t)(u.pm * 2 + 1) * 2 + bj) * 5632 + ch0 + 4 * n) = acc[1][bj][3][n] * rs[7]; }
            }
        }
        if (fr == 0 && wr == 0) {
#pragma unroll
            for (int bj = 0; bj < 2; ++bj)
#pragma unroll
                for (int n = 0; n < 2; ++n) { *(f32x4*)(yf + ((size_t)(u.pm * 2 + 0) * 2 + bj) * 5632 + ch0 + 4 * n) = acc[0][bj][0][n] * rs[0]; *(f32x4*)(yf + ((size_t)(u.pm * 2 + 1) * 2 + bj) * 5632 + ch0 + 4 * n) = acc[0][bj][1][n] * rs[1]; }
        }
        asm volatile("s_waitcnt lgkmcnt(0)" ::: "memory"); __builtin_amdgcn_s_barrier(); asm volatile("" ::: "memory");
#pragma unroll
        for (int n = 0; n < 2; ++n) {
            f32x4 w[2][3], bb[2];
#pragma unroll
            for (int bj = 0; bj < 2; ++bj) { const int c = bj * 5632 + ch0 + 4 * n; bb[bj] = *(const f32x4*)(cb + c);
#pragma unroll
                for (int i = 0; i < 3; ++i) w[bj][i] = *(const f32x4*)(cw + (size_t)i * 11264 + c); }
            f32x4 o[8];
#pragma unroll
            for (int e = 0; e < 4; ++e) {
                float c2[2][8];
#pragma unroll
                for (int bj = 0; bj < 2; ++bj) {
                    float y[8];
#pragma unroll
                    for (int j = 0; j < 8; ++j) y[j] = acc[j >> 2][bj][j & 3][n][e] * rs[j];
                    float x6 = 0.f, x7 = 0.f;
                    if (wr == 1) { x6 = xw[((bj * 2 + n) * 4 + e) * 2 + 0]; x7 = xw[((bj * 2 + n) * 4 + e) * 2 + 1]; }
                    const float p6 = __uint_as_float(__builtin_amdgcn_update_dpp(__float_as_uint(x6), __float_as_uint(y[6]), 0x111, 0xf, 0xf, false));
                    const float p7 = __uint_as_float(__builtin_amdgcn_update_dpp(__float_as_uint(x7), __float_as_uint(y[7]), 0x111, 0xf, 0xf, false));
                    const float w0 = w[bj][0][e], w1 = w[bj][1][e], w2 = w[bj][2][e], b0 = bb[bj][e];
                    c2[bj][0] = b0 + w0 * p6 + w1 * p7 + w2 * y[0];
                    c2[bj][1] = b0 + w0 * p7 + w1 * y[0] + w2 * y[1];
#pragma unroll
                    for (int j = 2; j < 8; ++j) c2[bj][j] = b0 + w0 * y[j - 2] + w1 * y[j - 1] + w2 * y[j];
                }
#pragma unroll
                for (int j = 0; j < 8; ++j) { const float G = c2[0][j]; o[j][e] = G * sigmoidf_(G) * c2[1][j]; }
            }
#pragma unroll
            for (int j = 0; j < 8; ++j) { u32x2_ pk; pk[0] = cvt_pk_bf16(o[j][0], o[j][1]); pk[1] = cvt_pk_bf16(o[j][2], o[j][3]); *(u32x2_*)(act + (size_t)(row0 + j) * 5632 + ch0 + 4 * n) = pk; }
            asm volatile("" ::: "memory");
        }
    }
};
template <class Epi, class Sched, bool ALIGN_EPI = false, bool SP2 = false>
__device__ __forceinline__ void gemm_phase(PG8_LAS unsigned char* lds, const Gemm g, const Sched& S, const Epi& E, const int wave_s) {
    int tid_op; asm volatile("v_mbcnt_lo_u32_b32 %0, -1, 0\n\tv_mbcnt_hi_u32_b32 %0, -1, %0" : "=v"(tid_op)); tid_op += wave_s * 64;
    const int tid = tid_op, wid = __builtin_amdgcn_readfirstlane(tid >> 6), lane = tid & 63, wr = wid >> 2, wc = wid & 3, fr = lane & 15, fq = lane >> 4;
    const int K = g.K, nt = K / BK;
    unsigned voffA[2], voffB[2];
#pragma unroll
    for (int i = 0; i < 2; ++i) { int R, C; stage_rc(tid * 16 + i * 8192, R, C); const int Rb = Epi::PERM ? ((R & ~31) + perm32(R & 31)) : R;
        const int Ra = Epi::APERM ? (128 * (R >> 6) + 8 * (R & 15) + ((R >> 4) & 3)) : R;
        voffA[i] = (unsigned)(Ra * K + C) * 2u; voffB[i] = (unsigned)(Rb * K + C) * 2u; }
    const size_t kstep = (size_t)(BK * 2);
    const size_t hstep = (size_t)HALF * K * 2;
    const size_t hstepA = Epi::APERM ? (size_t)4 * K * 2 : hstep;
    const size_t tstep = 2 * hstep;
    const unsigned ldsw = (unsigned)wid * 1024u;
    const int aoff = lds_byte(wr * 64 + fr, fq * 8), boff = lds_byte(wc * 32 + fr, fq * 8);
#define PG8_SA(b, h) (((b) * 2 + (h)) * HTB)
#define PG8_SB(b, h) ((4 + (b) * 2 + (h)) * HTB)
#define PG8_STAGE(bufoff, gbase, voff) do { _Pragma("unroll") for (int _i = 0; _i < 2; ++_i) \
        __builtin_amdgcn_global_load_lds((const unsigned*)((const char*)(gbase) + (voff)[_i]), (PG8_LAS unsigned*)(lds + (bufoff) + ldsw + _i * 8192), 16, 0, 0); } while (0)
#define PG8_LDA(dst, b, h) do { _Pragma("unroll") for (int m = 0; m < 4; ++m) _Pragma("unroll") for (int k = 0; k < 2; ++k) dst[m][k] = *(const PG8_LAS bf16x8*)(lds + PG8_SA(b, h) + aoff + m * 2048 + k * 1024); } while (0)
#define PG8_LDB(dst, b, h) do { _Pragma("unroll") for (int n = 0; n < 2; ++n) _Pragma("unroll") for (int k = 0; k < 2; ++k) dst[n][k] = *(const PG8_LAS bf16x8*)(lds + PG8_SB(b, h) + boff + n * 2048 + k * 1024); } while (0)
#define PG8_MMA(ai, bj, At, Bt) do { __builtin_amdgcn_s_setprio(1); _Pragma("unroll") for (int m = 0; m < 4; ++m) _Pragma("unroll") for (int n = 0; n < 2; ++n) _Pragma("unroll") for (int k = 0; k < 2; ++k) \
        acc[ai][bj][m][n] = __builtin_amdgcn_mfma_f32_16x16x32_bf16(Bt[n][k], At[m][k], acc[ai][bj][m][n], 0, 0, 0); __builtin_amdgcn_s_setprio(0); } while (0)
#define PG8_WAIT_V(n) asm volatile("s_waitcnt vmcnt(" #n ")" ::: "memory")
#define PG8_WAIT_L(n) asm volatile("s_waitcnt lgkmcnt(" #n ")" ::: "memory")
#define PG8_BAR __builtin_amdgcn_s_barrier()
#define PG8_SCHED __builtin_amdgcn_sched_barrier(0)
    Unit cur, nxt; int ui = 0;
    if (!S.next(0, cur)) return;
    f32x4 acc[2][2][4][2];
#pragma unroll
    for (int a = 0; a < 2; ++a)
#pragma unroll
        for (int b = 0; b < 2; ++b)
#pragma unroll
            for (int m = 0; m < 4; ++m)
#pragma unroll
                for (int n = 0; n < 2; ++n) { float z_ = 0.f; asm volatile("" : "+v"(z_)); acc[a][b][m][n] = (f32x4){z_, z_, z_, z_}; }
    bf16x8 At[4][2], B0[2][2], B1[2][2];
    const char* cA = (const char*)g.A + (size_t)cur.pm * tstep; const char* cB = (const char*)g.Bt + (size_t)cur.pn * tstep;
    S.a_ready(cur);
    if constexpr (SP2) {
        PG8_STAGE(PG8_SB(0, 0), cB, voffB); PG8_STAGE(PG8_SB(0, 1), cB + hstep, voffB); PG8_STAGE(PG8_SA(0, 0), cA, voffA); PG8_STAGE(PG8_SA(0, 1), cA + hstepA, voffA);
        if (wr == 1) PG8_BAR;
        PG8_WAIT_V(2); PG8_BAR;
        PG8_STAGE(PG8_SB(1, 0), cB + kstep, voffB); PG8_STAGE(PG8_SA(1, 0), cA + kstep, voffA); PG8_STAGE(PG8_SB(1, 1), cB + hstep + kstep, voffB);
        PG8_WAIT_V(6); PG8_BAR;
    } else {
        PG8_STAGE(PG8_SB(0, 0), cB, voffB); PG8_STAGE(PG8_SA(0, 0), cA, voffA); PG8_STAGE(PG8_SB(0, 1), cB + hstep, voffB); PG8_STAGE(PG8_SA(0, 1), cA + hstepA, voffA);
        if (wr == 1) PG8_BAR;
        PG8_WAIT_V(4); PG8_BAR;
        PG8_STAGE(PG8_SB(1, 0), cB + kstep, voffB); PG8_STAGE(PG8_SA(1, 0), cA + kstep, voffA); PG8_STAGE(PG8_SB(1, 1), cB + hstep + kstep, voffB);
        PG8_WAIT_V(6); PG8_BAR;
    }
    for (;;) {
        const bool has_next = S.next(ui + 1, nxt);
        const char* nA = has_next ? (const char*)g.A + (size_t)nxt.pm * tstep : cA; const char* nB = has_next ? (const char*)g.Bt + (size_t)nxt.pn * tstep : cB;
        for (int t = 0; t < nt; t += 2) {
            const bool last = (t == nt - 2);
            const char* a1 = cA + (size_t)(t + 1) * kstep;
            const char* a2 = last ? nA : cA + (size_t)(t + 2) * kstep; const char* b2 = last ? nB : cB + (size_t)(t + 2) * kstep;
            const char* a3 = a2 + kstep; const char* b3 = b2 + kstep;
            if (last && has_next) S.a_ready(nxt);
            if constexpr (SP2) {
            PG8_LDB(B0, 0, 0); PG8_LDB(B1, 0, 1); PG8_SCHED; PG8_LDA(At, 0, 0); PG8_STAGE(PG8_SA(1, 1), a1 + hstepA, voffA);
            PG8_WAIT_V(8); PG8_WAIT_L(0); PG8_BAR; PG8_MMA(0, 0, At, B0); PG8_MMA(0, 1, At, B1); PG8_BAR; PG8_SCHED;
            PG8_LDA(At, 0, 1); PG8_STAGE(PG8_SB(0, 0), b2, voffB); PG8_STAGE(PG8_SB(0, 1), b2 + hstep, voffB); PG8_STAGE(PG8_SA(0, 0), a2, voffA);
            PG8_WAIT_V(8); PG8_WAIT_L(0); PG8_BAR; PG8_MMA(1, 0, At, B0); PG8_MMA(1, 1, At, B1); PG8_BAR; PG8_SCHED;
            PG8_LDB(B0, 1, 0); PG8_LDB(B1, 1, 1); PG8_SCHED; PG8_LDA(At, 1, 0); PG8_STAGE(PG8_SA(0, 1), a2 + hstepA, voffA);
            PG8_WAIT_V(8); PG8_WAIT_L(0); PG8_BAR; PG8_MMA(0, 0, At, B0); PG8_MMA(0, 1, At, B1); PG8_BAR; PG8_SCHED;
            PG8_LDA(At, 1, 1); PG8_STAGE(PG8_SB(1, 0), b3, voffB); PG8_STAGE(PG8_SB(1, 1), b3 + hstep, voffB); PG8_STAGE(PG8_SA(1, 0), a3, voffA);
            PG8_WAIT_V(8); PG8_WAIT_L(0); PG8_BAR; PG8_MMA(1, 0, At, B0); PG8_MMA(1, 1, At, B1); PG8_BAR; PG8_SCHED;
            } else {
            PG8_LDB(B0, 0, 0); PG8_SCHED; PG8_LDA(At, 0, 0); PG8_STAGE(PG8_SA(1, 1), a1 + hstepA, voffA);
            PG8_WAIT_L(8); PG8_BAR; PG8_WAIT_L(0); PG8_MMA(0, 0, At, B0); PG8_BAR; PG8_SCHED;
            PG8_LDB(B1, 0, 1); PG8_STAGE(PG8_SB(0, 0), b2, voffB);
            PG8_BAR; PG8_WAIT_L(0); PG8_MMA(0, 1, At, B1); PG8_BAR;
            PG8_LDA(At, 0, 1); PG8_STAGE(PG8_SA(0, 0), a2, voffA);
            PG8_BAR; PG8_WAIT_L(0); PG8_MMA(1, 0, At, B0); PG8_BAR; PG8_SCHED;
            PG8_STAGE(PG8_SB(0, 1), b2 + hstep, voffB);
            PG8_WAIT_V(6); PG8_BAR; PG8_MMA(1, 1, At, B1); PG8_BAR;
            PG8_LDB(B0, 1, 0); PG8_SCHED; PG8_LDA(At, 1, 0); PG8_STAGE(PG8_SA(0, 1), a2 + hstepA, voffA);
            PG8_WAIT_L(8); PG8_BAR; PG8_WAIT_L(0); PG8_MMA(0, 0, At, B0); PG8_BAR; PG8_SCHED;
            PG8_LDB(B1, 1, 1); PG8_STAGE(PG8_SB(1, 0), b3, voffB);
            PG8_BAR; PG8_WAIT_L(0); PG8_MMA(0, 1, At, B1); PG8_BAR;
            PG8_LDA(At, 1, 1); PG8_STAGE(PG8_SA(1, 0), a3, voffA);
            PG8_BAR; PG8_WAIT_L(0); PG8_MMA(1, 0, At, B0); PG8_BAR; PG8_SCHED;
            PG8_STAGE(PG8_SB(1, 1), b3 + hstep, voffB);
            PG8_WAIT_V(6); PG8_BAR; PG8_MMA(1, 1, At, B1); PG8_BAR;
            }
        }
        if constexpr (ALIGN_EPI) { if (wr == 0) PG8_BAR; }
        if constexpr (!Epi::AFTER_DRAIN) { E(acc, cur, wr, wc, fr, fq); S.done(cur); }
        if (!has_next) break;
#pragma unroll
        for (int a = 0; a < 2; ++a)
#pragma unroll
            for (int b = 0; b < 2; ++b)
#pragma unroll
                for (int m = 0; m < 4; ++m)
#pragma unroll
                    for (int n = 0; n < 2; ++n) { float z_ = 0.f; asm volatile("" : "+v"(z_)); acc[a][b][m][n] = (f32x4){z_, z_, z_, z_}; }
        cur = nxt; cA = nA; cB = nB; ++ui;
        if constexpr (ALIGN_EPI) { if (wr == 1) PG8_BAR; }
    }
    PG8_WAIT_V(0);
    if constexpr (!ALIGN_EPI) { if (wr == 0) PG8_BAR; }
    PG8_BAR;
    if constexpr (Epi::AFTER_DRAIN) { E.fused(acc, cur, wr, wc, fr, fq, lds, wid, lane); S.done(cur); }
#undef PG8_SA
#undef PG8_SB
#undef PG8_STAGE
#undef PG8_LDA
#undef PG8_LDB
#undef PG8_MMA
#undef PG8_WAIT_V
#undef PG8_WAIT_L
#undef PG8_BAR
#undef PG8_SCHED
}
}
#define GAS __attribute__((address_space(1)))
#define LAS __attribute__((address_space(3)))
typedef unsigned short bf16;
typedef unsigned v4u __attribute__((ext_vector_type(4)));
typedef unsigned v2u __attribute__((ext_vector_type(2)));
typedef float f32x4 __attribute__((ext_vector_type(4)));
typedef float f32x2 __attribute__((ext_vector_type(2)));
typedef float f32x16 __attribute__((ext_vector_type(16)));
typedef short bf16x8 __attribute__((ext_vector_type(8)));
typedef short s16x4 __attribute__((ext_vector_type(4)));
#define LDS_WAIT() asm volatile("s_waitcnt lgkmcnt(0)" ::: "memory")

constexpr int LDS_BYTES = 147456;

__device__ __forceinline__ unsigned f2bf(float f) { unsigned u = __builtin_bit_cast(unsigned, f); return (u + 0x7fffu + ((u >> 16) & 1u)) >> 16; }
__device__ __forceinline__ unsigned pk2(float lo, float hi) { return pg8::cvt_pk_bf16(lo, hi); }
__device__ __forceinline__ float wave_sum(float v) { return pg8::wave_sum_(v); }
__device__ __forceinline__ int crow(int r, int hi) { return (r & 3) + 8 * (r >> 2) + 4 * hi; }

__device__ __forceinline__ int rowmap(int mode, int n) {
    if (mode == 1) {
#ifdef DBG_SWAPW
        if (n >= 1024 && n < 3072) return n < 2048 ? n + 1024 : n - 1024;
#endif
        if (n < 4352) return n; if (n < 4416) { const int i = n - 4352; return 8448 + (i < 32 ? 2 * i : 2 * (i - 32) + 1); } return n - 64; }
    if (mode == 2) { const int hh = n / 192, c = n - hh * 192; if (c < 128) return n; const int i = c - 128; return hh * 192 + 128 + (i < 32 ? 2 * i : 2 * (i - 32) + 1); }
    if (mode == 3) { if (n < DFF) return (n >> 7) * 256 + (n & 127); const int n2 = n - DFF; return (n2 >> 7) * 256 + 128 + (n2 & 127); }
    return n;
}
__device__ __forceinline__ void conv_item(const float* W, int K, int N, bf16* WT, int mode, const float* ksc, LAS float* scr, int item, int lane) {
    const int nblk = N / 64, kb = item / nblk, nb = item - kb * nblk, k0 = 64 * kb, n0 = 64 * nb;
#pragma unroll 8
    for (int i = 0; i < 16; ++i) { const int kk = 4 * i + (lane >> 4); const f32x4 v = *(const f32x4*)(W + (size_t)(k0 + kk) * N + n0 + 4 * (lane & 15)); const float s = ksc ? ksc[k0 + kk] : 1.0f;
        LAS float* d = scr + kk * 65 + 4 * (lane & 15); d[0] = v[0] * s; d[1] = v[1] * s; d[2] = v[2] * s; d[3] = v[3] * s; }
    LDS_WAIT();
    const int c = lane & 7;
#pragma unroll
    for (int j = 0; j < 8; ++j) { const int n = (lane >> 3) + 8 * j; const LAS float* s = scr + (8 * c) * 65 + n;
        v4u o; o.x = pk2(s[0 * 65], s[1 * 65]); o.y = pk2(s[2 * 65], s[3 * 65]); o.z = pk2(s[4 * 65], s[5 * 65]); o.w = pk2(s[6 * 65], s[7 * 65]);
        *(v4u*)(WT + (size_t)rowmap(mode, n0 + n) * K + k0 + 8 * c) = o; }
    LDS_WAIT();
}

struct Args {
    const float* in[17]; float* out; unsigned char* ws; int ph_lo, ph_hi;
};

__device__ __forceinline__ void norm_rows(const float* X, const float* g, bf16* outb, float* outf, int gw, int NGW, int lane) {
    for (int m = gw; m < T_; m += NGW) {
        const f32x4* xr = (const f32x4*)(X + (size_t)m * DM) + lane; f32x4 v[8]; float ss = 0.f;
#pragma unroll
        for (int j = 0; j < 8; ++j) { v[j] = xr[64 * j]; ss += (v[j][0] * v[j][0] + v[j][1] * v[j][1]) + (v[j][2] * v[j][2] + v[j][3] * v[j][3]); }
        const float rstd = 1.0f / sqrtf(wave_sum(ss) * (1.0f / DM) + 1e-6f);
#pragma unroll
        for (int j = 0; j < 8; ++j) { const f32x4 gv = ((const f32x4*)g)[lane + 64 * j]; const f32x4 o = v[j] * rstd * gv;
            if (outb) { v2u w; w.x = pk2(o[0], o[1]); w.y = pk2(o[2], o[3]); *(v2u*)(outb + (size_t)m * DM + 4 * (lane + 64 * j)) = w; }
            else *((f32x4*)(outf + (size_t)m * DM) + lane + 64 * j) = o; }
    }
}

__device__ __forceinline__ void unpack8(const v4u w, float (&f)[8]) { f[0] = pg8::bf_lo(w.x); f[1] = pg8::bf_hi(w.x); f[2] = pg8::bf_lo(w.y); f[3] = pg8::bf_hi(w.y); f[4] = pg8::bf_lo(w.z); f[5] = pg8::bf_hi(w.z); f[6] = pg8::bf_lo(w.w); f[7] = pg8::bf_hi(w.w); }
__device__ __forceinline__ void conv_act_half(const bf16* Y, bf16* ACT, const float* cw, const float* cb, int gtid, int NT) {
    constexpr int NCG = DFF / 8, NRB = 8192 / 32;
    for (int idx = gtid; idx < NCG * NRB; idx += NT) {
        const int rb = idx / NCG, cgi = idx - rb * NCG, c0 = 8 * cgi, vg = (c0 >> 7) * 256 + (c0 & 127), vv = vg + 128;
        float wg[3][8], wv[3][8], bg[8], bv[8];
#pragma unroll
        for (int i = 0; i < 3; ++i)
#pragma unroll
            for (int e = 0; e < 8; ++e) { wg[i][e] = cw[(size_t)i * 2 * DFF + c0 + e]; wv[i][e] = cw[(size_t)i * 2 * DFF + DFF + c0 + e]; }
#pragma unroll
        for (int e = 0; e < 8; ++e) { bg[e] = cb[c0 + e]; bv[e] = cb[DFF + c0 + e]; }
        const int r0 = rb * 32;
        float g2[8], g1[8], v2[8], v1[8];
        if ((r0 & (SEQ_ - 1)) == 0) {
#pragma unroll
            for (int e = 0; e < 8; ++e) { g2[e] = 0.f; g1[e] = 0.f; v2[e] = 0.f; v1[e] = 0.f; }
        } else {
            unpack8(*(const v4u*)(Y + (size_t)(r0 - 2) * (2 * DFF) + vg), g2); unpack8(*(const v4u*)(Y + (size_t)(r0 - 1) * (2 * DFF) + vg), g1);
            unpack8(*(const v4u*)(Y + (size_t)(r0 - 2) * (2 * DFF) + vv), v2); unpack8(*(const v4u*)(Y + (size_t)(r0 - 1) * (2 * DFF) + vv), v1);
        }
#pragma unroll 8
        for (int k = 0; k < 32; ++k) { const int r = r0 + k; float g0[8], v0[8], o[8];
            unpack8(*(const v4u*)(Y + (size_t)r * (2 * DFF) + vg), g0); unpack8(*(const v4u*)(Y + (size_t)r * (2 * DFF) + vv), v0);
#pragma unroll
            for (int e = 0; e < 8; ++e) { const float G = bg[e] + wg[0][e] * g2[e] + wg[1][e] * g1[e] + wg[2][e] * g0[e], V = bv[e] + wv[0][e] * v2[e] + wv[1][e] * v1[e] + wv[2][e] * v0[e];
                o[e] = G * pg8::sigmoidf_(G) * V; g2[e] = g1[e]; g1[e] = g0[e]; v2[e] = v1[e]; v1[e] = v0[e]; }
            v4u w; w.x = pk2(o[0], o[1]); w.y = pk2(o[2], o[3]); w.z = pk2(o[4], o[5]); w.w = pk2(o[6], o[7]);
            *(v4u*)(ACT + (size_t)r * DFF + c0) = w; }
    }
}

__device__ __forceinline__ s16x4 vtr(const LAS unsigned char* p) { return __builtin_bit_cast(s16x4, __builtin_amdgcn_ds_read_tr16_b64_v4i16((LAS s16x4*)p)); }
#define MFMA32(a, b, c) __builtin_amdgcn_mfma_f32_32x32x16_bf16((a), (b), (c), 0, 0, 0)

__device__ __forceinline__ void sb_unit(const bf16* Q, const bf16* K, const bf16* V, bf16* O, int b, int h, int qb, LAS unsigned char* lds, const int wave_s, const bool do_store = true) {
    int tid_op; asm volatile("v_mbcnt_lo_u32_b32 %0, -1, 0\n\tv_mbcnt_hi_u32_b32 %0, -1, %0" : "=v"(tid_op)); tid_op += wave_s * 64;
    const int tid = tid_op, lane = tid & 63, r32 = lane & 31, hi = lane >> 5, wid = __builtin_amdgcn_readfirstlane(tid >> 6);
    LAS unsigned char* vl = lds + wid * 10240;
    const int q0 = qb * 256 + wid * 32; const size_t rowbase = (size_t)b * SEQ_;
    const bf16* Qp = Q + (rowbase + q0 + r32) * 1024 + h * 128 + hi * 8;
    bf16x8 qf[8];
#pragma unroll
    for (int kk = 0; kk < 8; ++kk) qf[kk] = *(const bf16x8*)(Qp + 16 * kk);
    f32x16 o[4];
#pragma unroll
    for (int d = 0; d < 4; ++d)
#pragma unroll
        for (int r = 0; r < 16; ++r) o[d][r] = 0.f;
    float carry = 0.f;
    const int trofs = (4 * hi + ((lane & 15) >> 2)) * 320 + (((lane >> 4) & 1) * 16 + (lane & 3) * 4) * 2;
    for (int kb = q0; kb >= 0; kb -= 32) {
        const bf16* Kp = K + (rowbase + kb + r32) * 1024 + h * 128 + hi * 8;
        bf16x8 kf[8];
#pragma unroll
        for (int kk = 0; kk < 8; ++kk) kf[kk] = *(const bf16x8*)(Kp + 16 * kk);
        v4u vv[8];
#pragma unroll
        for (int i = 0; i < 8; ++i) { const int c = i * 64 + lane, row = c >> 4, ch = c & 15; vv[i] = *(const v4u*)(V + (rowbase + kb + row) * 1024 + h * 128 + ch * 8); }
        f32x16 p;
#pragma unroll
        for (int r = 0; r < 16; ++r) p[r] = 0.f;
#pragma unroll
        for (int kk = 0; kk < 8; ++kk) p = MFMA32(kf[kk], qf[kk], p);
        LDS_WAIT();
#pragma unroll
        for (int i = 0; i < 8; ++i) { const int c = i * 64 + lane, row = c >> 4, ch = c & 15; *(LAS v4u*)(vl + row * 320 + ch * 16) = vv[i]; }
        const bool diag = (kb == q0);
        float lf[16], ls[16];
#pragma unroll
        for (int r = 0; r < 16; ++r) { const float z = p[r], e = __builtin_amdgcn_exp2f(-fabsf(z)), L = __builtin_amdgcn_logf(1.0f + e);
            lf[r] = -(fmaxf(z, 0.f) + L); ls[r] = fminf(z, 0.f) - L;
            if (diag && !(crow(r, hi) < r32)) { lf[r] = 0.f; ls[r] = -INFINITY; } }
        float G[4], Go[4];
#pragma unroll
        for (int g = 0; g < 4; ++g) { G[g] = (lf[4 * g] + lf[4 * g + 1]) + (lf[4 * g + 2] + lf[4 * g + 3]); Go[g] = pg8::xother32(G[g], hi); }
        float Tg[4]; Tg[3] = 0.f; Tg[2] = G[3] + Go[3]; Tg[1] = Tg[2] + (G[2] + Go[2]); Tg[0] = Tg[1] + (G[1] + Go[1]);
        const float total = Tg[0] + (G[0] + Go[0]);
        float a[16];
#pragma unroll
        for (int g = 0; g < 4; ++g) { const float base = carry + Tg[g] + (hi == 0 ? Go[g] : 0.f);
            const float s3 = base, s2 = s3 + lf[4 * g + 3], s1 = s2 + lf[4 * g + 2], s0 = s1 + lf[4 * g + 1];
            a[4 * g + 3] = __builtin_amdgcn_exp2f(ls[4 * g + 3] + s3); a[4 * g + 2] = __builtin_amdgcn_exp2f(ls[4 * g + 2] + s2);
            a[4 * g + 1] = __builtin_amdgcn_exp2f(ls[4 * g + 1] + s1); a[4 * g + 0] = __builtin_amdgcn_exp2f(ls[4 * g + 0] + s0); }
        carry += total;
        bf16x8 pw[2];
#pragma unroll
        for (int s = 0; s < 2; ++s) { v4u w; w.x = pk2(a[8 * s], a[8 * s + 1]); w.y = pk2(a[8 * s + 2], a[8 * s + 3]); w.z = pk2(a[8 * s + 4], a[8 * s + 5]); w.w = pk2(a[8 * s + 6], a[8 * s + 7]); pw[s] = __builtin_bit_cast(bf16x8, w); }
        LDS_WAIT();
#pragma unroll
        for (int db = 0; db < 4; ++db)
#pragma unroll
            for (int s = 0; s < 2; ++s) { const s16x4 lo = vtr(vl + trofs + (16 * s) * 320 + db * 64), hh = vtr(vl + trofs + (16 * s + 8) * 320 + db * 64);
                const bf16x8 A = (bf16x8){lo[0], lo[1], lo[2], lo[3], hh[0], hh[1], hh[2], hh[3]};
                o[db] = MFMA32(A, pw[s], o[db]); if (s == 1) __builtin_amdgcn_sched_barrier(0); }
        if (__all(carry < -160.0f)) break;
    }
    bf16* Op = O + (rowbase + q0 + r32) * 1024 + h * 128 + 4 * hi;
    if (do_store) {
#pragma unroll
    for (int db = 0; db < 4; ++db)
#pragma unroll
        for (int g = 0; g < 4; ++g) { v2u w; w.x = pk2(o[db][4 * g], o[db][4 * g + 1]); w.y = pk2(o[db][4 * g + 2], o[db][4 * g + 3]); *(v2u*)(Op + 32 * db + 8 * g) = w; }
    } else { float acc_ = 0.f;
#pragma unroll
      for (int db = 0; db < 4; ++db)
#pragma unroll
        for (int g = 0; g < 16; ++g) acc_ += o[db][g];
      if (acc_ == 1.2345e33f) Op[0] = 0; }
    LDS_WAIT();
}

constexpr int MLA_KB = 64 * 400, MLA_VB = 64 * 320, MLA_BUF = MLA_KB + MLA_VB;
__device__ __forceinline__ void mla_unit(const bf16* QM, const bf16* KV, const bf16* KR, bf16* O, int b, int h, int qb, LAS unsigned char* lds, const int wave_s) {
    int tid_op; asm volatile("v_mbcnt_lo_u32_b32 %0, -1, 0\n\tv_mbcnt_hi_u32_b32 %0, -1, %0" : "=v"(tid_op)); tid_op += wave_s * 64;
    const int tid = tid_op, lane = tid & 63, r32 = lane & 31, hi = lane >> 5, wid = __builtin_amdgcn_readfirstlane(tid >> 6);
    const int q0 = qb * 256 + wid * 32; const size_t rowbase = (size_t)b * SEQ_;
    const int NT = 4 * qb + 4, ntw = 4 * qb + (wid >> 1) + 1;
    const bf16* Qp = QM + (rowbase + q0 + r32) * 1536 + h * 192 + hi * 8;
    bf16x8 qf[12];
#pragma unroll
    for (int kk = 0; kk < 12; ++kk) qf[kk] = *(const bf16x8*)(Qp + 16 * kk);
    int krow[3], kch[3], vrow[2], vch[2];
#pragma unroll
    for (int i = 0; i < 3; ++i) { const int c = tid + 512 * i; krow[i] = c / 24; kch[i] = c - krow[i] * 24; }
#pragma unroll
    for (int i = 0; i < 2; ++i) { const int c = tid + 512 * i; vrow[i] = c >> 4; vch[i] = c & 15; }
    v4u kreg[3], vreg[2];
#define MLA_LOAD(t) do { \
    _Pragma("unroll") for (int i = 0; i < 3; ++i) { const size_t kr_ = rowbase + 64 * (t) + krow[i]; \
        kreg[i] = kch[i] < 16 ? *(const v4u*)(KV + kr_ * 2048 + h * 256 + kch[i] * 8) : *(const v4u*)(KR + kr_ * 64 + (kch[i] - 16) * 8); } \
    _Pragma("unroll") for (int i = 0; i < 2; ++i) { const size_t kr_ = rowbase + 64 * (t) + vrow[i]; vreg[i] = *(const v4u*)(KV + kr_ * 2048 + h * 256 + 128 + vch[i] * 8); } } while (0)
#define MLA_STORE(buf) do { \
    _Pragma("unroll") for (int i = 0; i < 3; ++i) *(LAS v4u*)(lds + (buf) * MLA_BUF + krow[i] * 400 + kch[i] * 16) = kreg[i]; \
    _Pragma("unroll") for (int i = 0; i < 2; ++i) *(LAS v4u*)(lds + (buf) * MLA_BUF + MLA_KB + vrow[i] * 320 + vch[i] * 16) = vreg[i]; } while (0)
    MLA_LOAD(0); MLA_STORE(0); __syncthreads();
    float m_ref = 0.f, l = 0.f; f32x16 o[4];
#pragma unroll
    for (int d = 0; d < 4; ++d)
#pragma unroll
        for (int r = 0; r < 16; ++r) o[d][r] = 0.f;
    const int trofs = (4 * hi + ((lane & 15) >> 2)) * 320 + (((lane >> 4) & 1) * 16 + (lane & 3) * 4) * 2;
    for (int t = 0; t < NT; ++t) {
        if (t + 1 < NT) MLA_LOAD(t + 1);
        if (t < ntw) {
            const LAS unsigned char* kb_ = lds + (t & 1) * MLA_BUF; const LAS unsigned char* vb_ = kb_ + MLA_KB;
            f32x16 p0, p1;
            { const float nm = -m_ref;
#pragma unroll
              for (int r = 0; r < 16; ++r) { p0[r] = nm; p1[r] = nm; } }
#pragma unroll
            for (int kk = 0; kk < 12; ++kk) { const bf16x8 a0 = *(const LAS bf16x8*)(kb_ + r32 * 400 + (16 * kk + 8 * hi) * 2), a1 = *(const LAS bf16x8*)(kb_ + (32 + r32) * 400 + (16 * kk + 8 * hi) * 2);
                p0 = MFMA32(a0, qf[kk], p0); p1 = MFMA32(a1, qf[kk], p1); if ((kk % 3) == 2) __builtin_amdgcn_sched_barrier(0); }
            float rm = fmaxf(p0[0], p1[0]);
#pragma unroll
            for (int r = 1; r < 16; ++r) rm = fmaxf(rm, fmaxf(p0[r], p1[r]));
            rm = pg8::xmax32(rm);
            if (t == 0 || __any(rm > 8.0f)) {
                const float d = (t == 0) ? rm : fmaxf(rm, 0.f), al = __builtin_amdgcn_exp2f(-d);
                if (t != 0) { l *= al;
#pragma unroll
                    for (int dd = 0; dd < 4; ++dd)
#pragma unroll
                        for (int r = 0; r < 16; ++r) o[dd][r] *= al; }
                m_ref += d;
#pragma unroll
                for (int r = 0; r < 16; ++r) { p0[r] -= d; p1[r] -= d; } }
            float sum = 0.f;
#pragma unroll
            for (int r = 0; r < 16; ++r) { p0[r] = __builtin_amdgcn_exp2f(p0[r]); p1[r] = __builtin_amdgcn_exp2f(p1[r]); sum += p0[r] + p1[r]; }
            l += sum;
            bf16x8 pw[4];
#pragma unroll
            for (int s = 0; s < 2; ++s) { v4u w; w.x = pk2(p0[8 * s], p0[8 * s + 1]); w.y = pk2(p0[8 * s + 2], p0[8 * s + 3]); w.z = pk2(p0[8 * s + 4], p0[8 * s + 5]); w.w = pk2(p0[8 * s + 6], p0[8 * s + 7]); pw[s] = __builtin_bit_cast(bf16x8, w);
                v4u x; x.x = pk2(p1[8 * s], p1[8 * s + 1]); x.y = pk2(p1[8 * s + 2], p1[8 * s + 3]); x.z = pk2(p1[8 * s + 4], p1[8 * s + 5]); x.w = pk2(p1[8 * s + 6], p1[8 * s + 7]); pw[2 + s] = __builtin_bit_cast(bf16x8, x); }
#pragma unroll
            for (int db = 0; db < 4; ++db)
#pragma unroll
                for (int s = 0; s < 4; ++s) { const s16x4 lo = vtr(vb_ + trofs + (16 * s) * 320 + db * 64), hh = vtr(vb_ + trofs + (16 * s + 8) * 320 + db * 64);
                    const bf16x8 A = (bf16x8){lo[0], lo[1], lo[2], lo[3], hh[0], hh[1], hh[2], hh[3]};
                    o[db] = MFMA32(A, pw[s], o[db]); if (s == 3) __builtin_amdgcn_sched_barrier(0); }
        }
        if (t + 1 < NT) MLA_STORE((t + 1) & 1);
        __syncthreads();
    }
#undef MLA_LOAD
#undef MLA_STORE
    const float lt = pg8::xsum32(l), inv = 1.0f / lt;
    bf16* Op = O + (rowbase + q0 + r32) * 1024 + h * 128 + 4 * hi;
#pragma unroll
    for (int db = 0; db < 4; ++db)
#pragma unroll
        for (int g = 0; g < 4; ++g) { v2u w; w.x = pk2(o[db][4 * g] * inv, o[db][4 * g + 1] * inv); w.y = pk2(o[db][4 * g + 2] * inv, o[db][4 * g + 3] * inv); *(v2u*)(Op + 32 * db + 8 * g) = w; }
}

#ifndef UPQ_ALIGN
#define UPQ_ALIGN true
#endif
#ifndef GATE_ALIGN
#define GATE_ALIGN true
#endif
#ifndef RES_ALIGN
#define RES_ALIGN false
#endif
#ifndef INPROJ_ALIGN
#define INPROJ_ALIGN false
#endif
#ifndef PHON0
#define PHON0 1
#endif
#ifndef PHON1
#define PHON1 1
#endif
#ifndef PHON2
#define PHON2 1
#endif
#ifndef PHON3
#define PHON3 1
#endif
#ifndef PHON4
#define PHON4 1
#endif
#ifndef PHON5
#define PHON5 1
#endif
#ifndef PHON6
#define PHON6 1
#endif
#ifndef PHON7
#define PHON7 1
#endif
#ifndef PHON8
#define PHON8 1
#endif
#ifndef PHON9
#define PHON9 1
#endif
#ifndef PHON13
#define PHON13 1
#endif
#define XB_TMO      128
#define XB_XCNT(j)  (256  + 64 * (j))
#define XB_XSUB(j)  (1280 + 64 * (j))
#define XB_XGEN(j)  (2304 + 64 * (j))
#define XB_TOP      3328
#define XB_TOPGEN   3392
#define XCD_BAR_WORDS 3456
#define XB_SPIN_CAP (1u << 18)

__device__ __forceinline__ unsigned xb_ld(unsigned* p)              { return __hip_atomic_load(p, __ATOMIC_RELAXED, __HIP_MEMORY_SCOPE_AGENT); }
__device__ __forceinline__ unsigned xb_add(unsigned* p, unsigned v) { return __hip_atomic_fetch_add(p, v, __ATOMIC_RELAXED, __HIP_MEMORY_SCOPE_AGENT); }
__device__ __forceinline__ unsigned xb_xcc_id() { return (unsigned)__builtin_amdgcn_s_getreg((3 << 11) | 20) & 0xFu; }
#define XB_SPIN(cond, bar) do { unsigned _sp = 0; while (cond) { __builtin_amdgcn_s_sleep(1); \
    if ((++_sp & 255u) == 0u) { if (xb_ld(&(bar)[XB_TMO])) break; if (_sp > XB_SPIN_CAP) { atomicAdd(&(bar)[XB_TMO], 1u); break; } } } } while (0)

struct XcdBarrier {
    unsigned* bar; unsigned x;
    volatile LAS unsigned* st;
};

__device__ __forceinline__ XcdBarrier xcd_barrier_post(unsigned* bar, volatile LAS unsigned* st, bool t0) {
    XcdBarrier b; b.bar = bar; b.x = xb_xcc_id(); b.st = st;
    if (t0) (void)xb_add(&bar[XB_XCNT(b.x)], 1u);
    return b;
}
__device__ __forceinline__ void xcd_barrier_complete(unsigned* bar, unsigned x, unsigned& nloc, unsigned& nx) {
    const unsigned G = gridDim.x * gridDim.y * gridDim.z;
    unsigned sum, cnt, mine, sp = 0u;
    for (;;) {
        sum = 0u; cnt = 0u; mine = 0u;
#pragma unroll
        for (unsigned j = 0; j < 16; ++j) { const unsigned c = xb_ld(&bar[XB_XCNT(j)]); sum += c; cnt += (c > 0u) ? 1u : 0u; mine = (j == x) ? c : mine; }
        if (sum == G) break;
        __builtin_amdgcn_s_sleep(1);
        if ((++sp & 255u) == 0u) { if (xb_ld(&bar[XB_TMO])) break; if (sp > XB_SPIN_CAP) { atomicAdd(&bar[XB_TMO], 1u); break; } }
    }
    nloc = mine > 0u ? mine : 1u; nx = cnt > 0u ? cnt : 1u;
}

__device__ __forceinline__ void xcd_barrier(const XcdBarrier& b, bool t0) {
    asm volatile("s_waitcnt vmcnt(0)" ::: "memory");
    __syncthreads();
    if (t0) {
        unsigned* bar = b.bar;
        __builtin_amdgcn_s_waitcnt(0);
        unsigned nloc = b.st[0], nx = b.st[1];
        if (nloc == 0u) { xcd_barrier_complete(bar, b.x, nloc, nx); b.st[0] = nloc; b.st[1] = nx; }
        const unsigned old = xb_add(&bar[XB_XSUB(b.x)], 1u);
        const unsigned gen = old / nloc;
        if (old + 1u == (gen + 1u) * nloc) {
            __builtin_amdgcn_fence(__ATOMIC_RELEASE, "agent");
            asm volatile("s_waitcnt vmcnt(0)" ::: "memory");
            const unsigned og = xb_add(&bar[XB_TOP], 1u);
            const unsigned tg = og / nx;
            if (og + 1u == (tg + 1u) * nx) xb_add(&bar[XB_TOPGEN], 1u);
            else XB_SPIN(xb_ld(&bar[XB_TOPGEN]) == tg, bar);
            __builtin_amdgcn_fence(__ATOMIC_ACQUIRE, "agent");
            xb_add(&bar[XB_XGEN(b.x)], 1u);
            asm volatile("s_waitcnt vmcnt(0)" ::: "memory");
        } else {
            XB_SPIN(xb_ld(&bar[XB_XGEN(b.x)]) == gen, bar);
            __builtin_amdgcn_fence(__ATOMIC_ACQUIRE, "agent");
            asm volatile("s_waitcnt vmcnt(0)" ::: "memory");
        }
    }
    __syncthreads();
}

constexpr int PH_PER_LAYER = 13, N_PHASES = 2 * PH_PER_LAYER + 1;
#define WSP(T, off) ((T*)(ws + (off)))
#define WSW(off) ((bf16*)(ws + (off) + (size_t)L * W_STRIDE))
typedef const __attribute__((address_space(4))) Args* CArgs;
__device__ __forceinline__ CArgs opq_(CArgs a) { asm volatile("" : "+s"(a)); return a; }
#define APIN(i) (opq_(ap)->in[i])
#define GET_TID() int tid; asm volatile("v_mbcnt_lo_u32_b32 %0, -1, 0\n\tv_mbcnt_hi_u32_b32 %0, -1, %0" : "=v"(tid)); const int lane = tid; tid += wave_s * 64;
constexpr int I_IN = 32 * 133, I_UQ = 12 * 24, I_UKV = 8 * 32, I_SB = 16 * 32, I_OUT = 32 * 32, I_UP = 32 * 176, I_DN = 88 * 32;
constexpr int NITEMS = I_IN + I_UQ + I_UKV + 2 * I_SB + I_OUT + I_UP + I_DN;
__device__ __forceinline__ void convert_items(CArgs ap, unsigned char* ws, const int L, const int first, const int stride, const int it1, LAS float* scr, const int lane) {
    const float* w_in = APIN(2) + (size_t)L * DM * NINSRC; const float* w_uq = APIN(5) + (size_t)L * 768 * 1536; const float* w_ukv = APIN(7) + (size_t)L * 512 * 2048;
    const float* w_sb = APIN(8) + (size_t)L * 1024 * DM; const float* w_mla = APIN(9) + (size_t)L * 1024 * DM; const float* w_out = APIN(10) + (size_t)L * DM * DM;
    const float* w_up = APIN(12) + (size_t)L * DM * 2 * DFF; const float* w_dn = APIN(15) + (size_t)L * DFF * DM;
    const float* qg = APIN(4) + L * 768; const float* kvg = APIN(6) + L * 512; const float* n2g = APIN(11) + L * DM;
#pragma unroll 1
    for (int it = first; it < it1; it += stride) {
        int r = it; const float* W; int K, N, mode = 0; bf16* WT; const float* ksc = nullptr;
        if (r < I_UP) { W = w_up; K = DM; N = 2 * DFF; WT = WSW(WS_WUP); mode = 3; ksc = n2g; }
        else if ((r -= I_UP) < I_IN) { W = w_in; K = DM; N = NINSRC; WT = WSW(WS_WIN); mode = 1; }
        else if ((r -= I_IN) < I_DN) { W = w_dn; K = DFF; N = DM; WT = WSW(WS_WDN); }
        else if ((r -= I_DN) < I_OUT) { W = w_out; K = DM; N = DM; WT = WSW(WS_WOUT); }
        else if ((r -= I_OUT) < I_SB) { W = w_sb; K = 1024; N = DM; WT = WSW(WS_WSB); }
        else if ((r -= I_SB) < I_SB) { W = w_mla; K = 1024; N = DM; WT = WSW(WS_WMLA); }
        else if ((r -= I_SB) < I_UQ) { W = w_uq; K = 768; N = 1536; WT = WSW(WS_WUQ); mode = 2; ksc = qg; }
        else { r -= I_UQ; W = w_ukv; K = 512; N = 2048; WT = WSW(WS_WUKV); ksc = kvg; }
        conv_item(W, K, N, WT, mode, ksc, scr, r, lane);
    }
}
constexpr int CV_A1 = 5120, CV_A2 = 10240;
__global__ void __launch_bounds__(NTHR, 2) hybrid_fwd(Args args_) {
    extern __shared__ __attribute__((aligned(16))) unsigned char lds_raw[];
    LAS unsigned char* lds = (LAS unsigned char*)lds_raw;
    cg::grid_group grid = cg::this_grid();
    const int lo = args_.ph_lo, hi_ph = args_.ph_hi;
    const int wave_s = __builtin_amdgcn_readfirstlane(threadIdx.x >> 6);
    volatile LAS unsigned* bar_st = (volatile LAS unsigned*)(lds + LDS_BYTES - 64);
    if (threadIdx.x < 16) bar_st[threadIdx.x] = 0u;
    __syncthreads();
    const bool t0_ = (threadIdx.x == 0);
    XcdBarrier xbar = xcd_barrier_post((unsigned*)(args_.ws + WS_BAR), bar_st, t0_);
    if (hi_ph - lo > 1) grid.sync();
#pragma unroll 1
    for (int ph = lo; ph < hi_ph; ++ph) {
        CArgs ap = (CArgs)__builtin_amdgcn_kernarg_segment_ptr(); asm volatile("" : "+s"(ap));
        int G_o = gridDim.x, bx_o = blockIdx.x; asm volatile("" : "+s"(G_o), "+s"(bx_o));
        const int wave = wave_s;
        const int G = G_o, bx = bx_o;
#ifdef DBG_DELAY
        for (int dl = 0; dl < DBG_DELAY; ++dl) __builtin_amdgcn_s_sleep(127);
#endif
        const int L = ph >= PH_PER_LAYER ? 1 : 0, k = ph - L * PH_PER_LAYER;
#ifdef REP_PHASE
        const int nrep_ = (k == REP_PHASE) ? 2 : 1;
#else
        const int nrep_ = 1;
#endif
#pragma unroll 1
        for (int rep_ = 0; rep_ < nrep_; ++rep_) {
        if (PHON0 && k == 0) {
            unsigned char* ws = opq_(ap)->ws; float* X2 = opq_(ap)->out;
            GET_TID();
            const int gw = bx * NWAVES + wave, NGW = G * NWAVES, gtid = bx * NTHR + tid, NTH = G * NTHR;
            LAS float* scr = (LAS float*)(lds + wave * 16640);
            if (L == 0 || G != 256) convert_items(ap, ws, L, gw, NGW, NITEMS, scr, lane);
            else convert_items(ap, ws, 1, CV_A1 + gw, NGW, NITEMS, scr, lane);
            { bf16* Winp = WSW(WS_WIN) + (size_t)NINSRC * DM;
              for (int i = gtid; i < 192 * DM / 8; i += NTH) { unsigned z_ = 0u; asm volatile("" : "+v"(z_)); ((v4u*)Winp)[i] = (v4u){z_, z_, z_, z_}; } }
            if (L == 0) {
                f32x2* ROPE = WSP(f32x2, WS_ROPE);
                for (int i = gtid; i < SEQ_ * 32; i += NTH) { const int t = i >> 5, f = i & 31;
                    double a = 1.0;
#pragma unroll 1
                    for (int q = 0; q < f; ++q) a *= 0.7498942093324559;
                    const double a2 = a * a; double c = 1.0, s = a, tc = 1.0, ts = a;
#pragma unroll 1
                    for (int q = 1; q <= 10; ++q) { const double d1 = (double)((2 * q - 1) * (2 * q)), d2 = (double)((2 * q) * (2 * q + 1)); tc = -tc * a2 / d1; ts = -ts * a2 / d2; c += tc; s += ts; }
                    double rc = 1.0, rs = 0.0;
#pragma unroll 1
                    for (int bit = 0; bit < 12; ++bit) { if ((t >> bit) & 1) { const double nc = rc * c - rs * s, ns = rc * s + rs * c; rc = nc; rs = ns; } const double c2 = c * c - s * s, s2 = 2.0 * c * s; c = c2; s = s2; }
                    ROPE[i] = (f32x2){(float)rc, (float)rs}; }
            }
            norm_rows(L == 0 ? APIN(0) : (const float*)X2, APIN(1) + L * DM, WSP(bf16, WS_HA), nullptr, gw, NGW, lane);
        } else if (PHON1 && k == 1) {
            unsigned char* ws = opq_(ap)->ws;
            float* SSQ = WSP(float, WS_SSQP);
            pg8::Gemm g{WSP(bf16, WS_HA), WSW(WS_WIN), T_, NIN, DM}; pg8::StaticOrder S; S.init(T_, NIN, G, bx);
            pg8::EpiInProj E{ws, SSQ, SSQ + 12 * T_, APIN(3) + L * 2 * DM};
            pg8::gemm_phase<pg8::EpiInProj, pg8::StaticOrder, INPROJ_ALIGN, true>(lds, g, S, E, wave_s);
            if (L == 0 && bx >= 128 && G == 256) { GET_TID(); (void)tid; convert_items(ap, ws, 1, (bx - 128) * NWAVES + wave, 128 * NWAVES, CV_A1, (LAS float*)(lds + wave * 16640), lane); __syncthreads(); }
        } else if (PHON2 && k == 2) {
            unsigned char* ws = opq_(ap)->ws;
            float* SSQ = WSP(float, WS_SSQP);
            { pg8::Gemm g{WSP(bf16, WS_CQ), WSW(WS_WUQ), T_, 1536, 768}; pg8::StaticOrder S; S.init(T_, 1536, G, bx); pg8::EpiQUp E{WSP(bf16, WS_QM), SSQ, WSP(f32x2, WS_ROPE)};
              pg8::gemm_phase<pg8::EpiQUp, pg8::StaticOrder, UPQ_ALIGN, true>(lds, g, S, E, wave_s); }
            { pg8::Gemm g{WSP(bf16, WS_CKV), WSW(WS_WUKV), T_, 2048, 512}; pg8::StaticOrder S; S.init(T_, 2048, G, bx); pg8::EpiKvUp E{WSP(bf16, WS_KV), SSQ + 12 * T_};
              pg8::gemm_phase<pg8::EpiKvUp, pg8::StaticOrder, UPQ_ALIGN, true>(lds, g, S, E, wave_s); }
#pragma unroll 1
            for (int p = bx; p < 256; p += G) { const int bh = p >> 3, s = p & 7;
#ifdef REP_SB
#pragma unroll 1
                for (int j = 0; j < 2; ++j) sb_unit(WSP(bf16, WS_SBQ), WSP(bf16, WS_SBK), WSP(bf16, WS_SBV), WSP(bf16, WS_SBQ), bh >> 3, bh & 7, j ? 15 - s : s, lds, wave_s, false);
#endif
#ifndef SKIP_SBATT
#pragma unroll 1
                for (int j = 0; j < 2; ++j) sb_unit(WSP(bf16, WS_SBQ), WSP(bf16, WS_SBK), WSP(bf16, WS_SBV), WSP(bf16, WS_SBQ), bh >> 3, bh & 7, j ? 15 - s : s, lds, wave_s);
#endif
            }
            __syncthreads();
        } else if (PHON3 && k == 3) {
            unsigned char* ws = opq_(ap)->ws;
#pragma unroll 1
            for (int p = bx; p < 256; p += G) { const int bh = p >> 3, s = p & 7;
#pragma unroll 1
                for (int j = 0; j < 2; ++j) mla_unit(WSP(bf16, WS_QM), WSP(bf16, WS_KV), WSP(bf16, WS_KR), WSP(bf16, WS_OMLA), bh >> 3, bh & 7, j ? 15 - s : s, lds, wave_s); }
        } else if (PHON4 && k == 4) {
            unsigned char* ws = opq_(ap)->ws;
            { pg8::Gemm g{WSP(bf16, WS_SBQ), WSW(WS_WSB), T_, DM, 1024}; pg8::StaticOrder S; S.init(T_, DM, G, bx); pg8::EpiGate<true> E{WSP(bf16, WS_GSB), WSP(float, WS_X1), nullptr};
              pg8::gemm_phase<pg8::EpiGate<true>, pg8::StaticOrder, GATE_ALIGN, true>(lds, g, S, E, wave_s); }
            { pg8::Gemm g{WSP(bf16, WS_OMLA), WSW(WS_WMLA), T_, DM, 1024}; pg8::StaticOrder S; S.init(T_, DM, G, bx); pg8::EpiGate<false> E{WSP(bf16, WS_GMLA), WSP(float, WS_X1), WSP(bf16, WS_MIX)};
              pg8::gemm_phase<pg8::EpiGate<false>, pg8::StaticOrder, GATE_ALIGN, true>(lds, g, S, E, wave_s); }
        } else if (PHON5 && k == 5) {
            unsigned char* ws = opq_(ap)->ws; float* X2 = opq_(ap)->out;
            pg8::Gemm g{WSP(bf16, WS_MIX), WSW(WS_WOUT), T_, DM, DM}; pg8::StaticOrder S; S.init(T_, DM, G, bx); pg8::EpiResidStat E{L == 0 ? APIN(0) : (const float*)X2, WSP(float, WS_X1), WSP(bf16, WS_HA), WSP(float, WS_SSQP)};
            pg8::gemm_phase<pg8::EpiResidStat, pg8::StaticOrder, RES_ALIGN, true>(lds, g, S, E, wave_s);
        } else if (PHON6 && k == 6) {
            unsigned char* ws = opq_(ap)->ws;
            GET_TID(); (void)lane;
            { const float* slots = WSP(float, WS_SSQP); float* rstd = WSP(float, WS_SSQ);
              for (int row = bx * NTHR + tid; row < T_; row += G * NTHR) { const f32x4* sp = (const f32x4*)(slots + (size_t)row * 32); f32x4 t = sp[0];
#pragma unroll
                  for (int j = 1; j < 8; ++j) t += sp[j];
                  rstd[row] = 1.0f / sqrtf(((t[0] + t[1]) + (t[2] + t[3])) * (1.0f / 2048.0f) + 1e-6f); } }
        } else if (PHON13 && k == 13) {
            unsigned char* ws = opq_(ap)->ws; float* X2 = opq_(ap)->out; (void)ws;
            GET_TID();
#ifdef DBG_DUMP
            {
                const bf16* src = (const bf16*)(ws + DBG_DUMP);
                for (size_t i = (size_t)(bx * NTHR + tid); i < (size_t)T_ * DM; i += (size_t)G * NTHR) X2[i] = pg8::bf_lo((unsigned)src[i]);
            }
            if (false) norm_rows(X2, APIN(16), nullptr, X2,
#elif defined(DBG_STOP) && !defined(DBG_FINAL_X2)
            norm_rows(WSP(float, WS_X1), APIN(16), nullptr, X2,
#else
            norm_rows(X2, APIN(16), nullptr, X2,
#endif
 bx * NWAVES + wave, G * NWAVES, lane);
        } else {
            unsigned char* ws = opq_(ap)->ws; float* X2 = opq_(ap)->out;
            if (PHON7 && k == 7) {
                pg8::Gemm g{WSP(bf16, WS_HA), WSW(WS_WUP), T_, 2 * DFF, DM}; pg8::StaticOrder S; S.init(T_, 2 * DFF, G, bx);
                pg8::EpiUpConv E{WSP(bf16, WS_ACT), WSP(float, WS_SSQ), APIN(13) + (size_t)L * 3 * 2 * DFF, APIN(14) + (size_t)L * 2 * DFF, WSP(float, WS_YL), WSP(float, WS_YF), (LAS float*)(lds + 131072)};
                pg8::gemm_phase<pg8::EpiUpConv, pg8::StaticOrder, true, true>(lds, g, S, E, wave_s);
            } else if (PHON8 && k == 8) {
                GET_TID(); (void)lane;
                const float* cw = APIN(13) + (size_t)L * 3 * 2 * DFF; const float* cb = APIN(14) + (size_t)L * 2 * DFF;
                const float* yl = WSP(float, WS_YL); const float* yf = WSP(float, WS_YF); bf16* act = WSP(bf16, WS_ACT);
                for (int idx = bx * NTHR + tid; idx < 64 * DFF; idx += G * NTHR) { const int pm = idx / DFF, ch = idx - pm * DFF;
                    if ((pm & 15) == 0) continue;
                    float c2[2][2];
#pragma unroll
                    for (int bj = 0; bj < 2; ++bj) { const int c = bj * DFF + ch; const float w0 = cw[c], w1 = cw[2 * DFF + c], w2 = cw[4 * DFF + c], b0 = cb[c];
                        const float l0 = yl[((size_t)((pm - 1) * 2 + 0) * 2 + bj) * DFF + ch], l1 = yl[((size_t)((pm - 1) * 2 + 1) * 2 + bj) * DFF + ch];
                        const float f0 = yf[((size_t)(pm * 2 + 0) * 2 + bj) * DFF + ch], f1 = yf[((size_t)(pm * 2 + 1) * 2 + bj) * DFF + ch];
                        c2[bj][0] = b0 + w0 * l0 + w1 * l1 + w2 * f0; c2[bj][1] = b0 + w0 * l1 + w1 * f0 + w2 * f1; }
#pragma unroll
                    for (int r = 0; r < 2; ++r) { const float Gv = c2[0][r]; act[(size_t)(pm * 256 + r) * DFF + ch] = (bf16)(pg8::cvt_pk_bf16(Gv * pg8::sigmoidf_(Gv) * c2[1][r], 0.f) & 0xffffu); }
                }
            } else if (PHON9 && k == 9) {
                pg8::Gemm g{WSP(bf16, WS_ACT), WSW(WS_WDN), T_, DM, DFF}; pg8::StaticOrder S; S.init(T_, DM, G, bx); pg8::EpiResid E{WSP(float, WS_X1), X2};
                pg8::gemm_phase<pg8::EpiResid, pg8::StaticOrder, RES_ALIGN, true>(lds, g, S, E, wave_s);
            }
        }
        }
        if (ph + 1 < hi_ph && !(k >= 10 && k <= 12)) { int l0_; asm volatile("v_mbcnt_lo_u32_b32 %0, -1, 0\n\tv_mbcnt_hi_u32_b32 %0, -1, %0" : "=v"(l0_)); xcd_barrier(xbar, wave_s == 0 && l0_ == 0);
#ifdef REP_BAR
            xcd_barrier(xbar, wave_s == 0 && l0_ == 0); xcd_barrier(xbar, wave_s == 0 && l0_ == 0);
#endif
        }
    }
}

#ifndef MK_PER_PHASE
#define MK_PER_PHASE 0
#endif
extern "C" void kernel_launch(void* const* d_in, const int* in_sizes, int n_in, void* d_out, int out_size, void* d_ws, size_t ws_size, hipStream_t stream) {
    static int grid = 0;
    if (grid == 0) {
        if (n_in != 17 || out_size != T_ * DM || ws_size < WS_END) { fprintf(stderr, "kernel_launch: unexpected shapes (n_in %d, out %d, ws %zu)\n", n_in, out_size, ws_size); grid = -1; return; }
        int dev = 0, cus = 0, per_cu = 0;
        hipGetDevice(&dev); hipDeviceGetAttribute(&cus, hipDeviceAttributeMultiprocessorCount, dev);
        hipFuncSetAttribute((const void*)hybrid_fwd, hipFuncAttributeMaxDynamicSharedMemorySize, LDS_BYTES);
        hipOccupancyMaxActiveBlocksPerMultiprocessor(&per_cu, (const void*)hybrid_fwd, NTHR, LDS_BYTES);
        (void)hipGetLastError();
        if (per_cu < 1) per_cu = 1;
        grid = cus * 1;
    }
    if (grid < 0) return;
#ifdef DBG_CLEAR_LO
    (void)hipMemsetAsync((char*)d_ws + (size_t)DBG_CLEAR_LO * MiB, 0, (size_t)(DBG_CLEAR_HI - DBG_CLEAR_LO) * MiB, stream);
#endif
    if (hipMemsetAsync((char*)d_ws + WS_BAR, 0, 16384, stream) != hipSuccess) { fprintf(stderr, "kernel_launch: memset of the barrier words failed\n"); return; }
    Args a{};
    for (int i = 0; i < 17; ++i) a.in[i] = (const float*)d_in[i];
    a.out = (float*)d_out; a.ws = (unsigned char*)d_ws;
#if MK_PER_PHASE
    for (int p = 0; p < N_PHASES; ++p) {
#ifdef DBG_STOP
        if (p >= DBG_STOP && p != N_PHASES - 1) continue;
#endif
        a.ph_lo = p; a.ph_hi = p + 1; void* kargs[] = {&a};
        hipError_t e = hipLaunchCooperativeKernel((const void*)hybrid_fwd, dim3(grid), dim3(NTHR), kargs, LDS_BYTES, stream);
        if (e != hipSuccess) { fprintf(stderr, "launch %d failed: %s\n", p, hipGetErrorString(e)); break; } }
#else
    a.ph_lo = 0; a.ph_hi = N_PHASES; void* kargs[] = {&a};
    hipError_t e = hipLaunchCooperativeKernel((const void*)hybrid_fwd, dim3(grid), dim3(NTHR), kargs, LDS_BYTES, stream);
    if (e != hipSuccess) fprintf(stderr, "cooperative launch failed: %s (grid %d)\n", hipGetErrorString(e), grid);
#endif
}
```
